# Optimizing an MI355X kernel written in HIP

```python
import jax, jax.numpy as jnp
from jax import lax
import numpy as np

D_MODEL = 1024
BATCH = 4
SEQ = 8192
DEPTH = 2

GRID_W = 64
CTX_LEN = 256
EPS = 1e-6
LN_EPS = 64e-5
MIX_W = D_MODEL
CHUNK = 128
A_GROUPS = 4
A_WIDTH = MIX_W // 2
A_GDIM = A_WIDTH // A_GROUPS
B_HEAD = 64
B_WIDTH = MIX_W // 2
B_HEADS = B_WIDTH // B_HEAD
DECAY_LORA = 64
AAA_LORA = 64
GATE_LORA = 128
C_WIDTH = MIX_W
C_HEADS = 4
C_HEAD = C_WIDTH // C_HEADS
QKV_BLOCK = 4
C_CHUNK = 128
D_FF = 2816
N_EVEN = (DEPTH + 1) // 2
N_ODD = DEPTH // 2
AB_IN = 2 * A_WIDTH + 3 * B_WIDTH + 2 * DECAY_LORA + 2 * AAA_LORA + GATE_LORA
C_IN = 2 * C_WIDTH + 4 * C_HEADS

kernel_name = 'hybrid_gmlp_rwkv7_mlstm_dit_block'


def rmsnorm(x, g):
    xf = x.astype(jnp.float32)
    y = xf * lax.rsqrt(jnp.mean(xf * xf, axis=-1, keepdims=True) + EPS)
    return (y * g).astype(x.dtype)


def modulate(h, shift, scale):
    return h * (1 + scale) + shift


def ada_mod(cvec, w, b):
    m = jax.nn.silu(cvec) @ w + b
    m = m.reshape(cvec.shape[:-1] + (6, D_MODEL))
    if cvec.ndim == 2:
        return [m[:, i, None, :] for i in range(6)]
    return [m[i] for i in range(6)]


def dwconv1d(x, w):
    xp = jnp.pad(x, ((0, 0), (1, 1), (0, 0)))
    return xp[:, :-2] * w[0] + xp[:, 1:-1] * w[1] + xp[:, 2:] * w[2]


def dwconv_grid(x, w, rows):
    bn, t, ch = x.shape
    y = lax.conv_general_dilated(x.reshape(bn, rows, GRID_W, ch), w[:, :, None, :],
                                 window_strides=(1, 1), padding='SAME',
                                 dimension_numbers=('NHWC', 'HWIO', 'NHWC'),
                                 feature_group_count=ch)
    return y.reshape(bn, t, ch)


def conv_ffn(h, w_up, conv_w, conv_b, w_down, rows):
    a, b = jnp.split(h @ w_up, 2, axis=-1)
    a = dwconv1d(a, conv_w[1]) if rows is None else dwconv_grid(a, conv_w, rows)
    return (jax.nn.gelu(a + conv_b) * b) @ w_down


def spatial_gate(p, w_s, b_s, g_v):
    bn, t, _ = p.shape
    u, v = jnp.split(jax.nn.gelu(p[..., :2 * A_WIDTH]), 2, axis=-1)
    v = rmsnorm(v.reshape(bn, t // CHUNK, CHUNK, A_GROUPS, A_GDIM), g_v)
    z = jnp.einsum('gpq,bnqgc->bnpgc', w_s, v) + b_s.T[None, None, :, :, None]
    return u * z.reshape(bn, t, A_WIDTH)


def rwkv_prep(p, b_shift, b_w0, b_w_up, b_a0, b_a_up, b_g_up, b_kk, b_ka):
    bn, t, _ = p.shape
    o = 2 * A_WIDTH
    r, k, v = jnp.split(dwconv1d(p[..., o:o + 3 * B_WIDTH], b_shift), 3, axis=-1)
    o += 3 * B_WIDTH
    wd = p[..., o:o + 2 * DECAY_LORA].reshape(bn, t, 2, DECAY_LORA)
    o += 2 * DECAY_LORA
    ad = p[..., o:o + 2 * AAA_LORA].reshape(bn, t, 2, AAA_LORA)
    o += 2 * AAA_LORA
    gd = p[..., o:o + GATE_LORA]
    logw = -jax.nn.softplus(-(b_w0 + jnp.einsum('btdr,drc->btdc', jnp.tanh(wd), b_w_up))) - 0.5
    decay = jnp.exp(-jnp.exp(logw.astype(jnp.float32)))
    a = jax.nn.sigmoid(b_a0 + jnp.einsum('btdr,drc->btdc', ad, b_a_up))
    g = jax.nn.sigmoid(gd) @ b_g_up
    hs = lambda u: u.reshape(u.shape[:-1] + (B_HEADS, B_HEAD))
    kk = hs(k * b_kk).astype(jnp.float32)
    kk = (kk * lax.rsqrt(jnp.maximum(jnp.sum(kk * kk, axis=-1, keepdims=True), 1e-12))).astype(k.dtype)
    k_dir = k[:, :, None, :] * (1 + (a - 1) * b_ka)
    return hs(r), hs(decay), hs(k_dir), hs(v), kk, hs(a), g


def rwkv_dir_inputs(prep, d):
    r, w, kd, v, kk, a, _ = prep
    seq = (r, w[:, :, d], kd[:, :, d], v, kk, kk * a[:, :, d])
    return tuple(u[:, ::-1] for u in seq) if d == 1 else seq


def rwkv7_scan(r, w, k, v, kk, b, s0):
    dt = r.dtype
    def step(s, inp):
        r_t, w_t, k_t, v_t, kk_t, b_t = inp
        sa = jnp.einsum('bhvk,bhk->bhv', s, kk_t)
        s = s * w_t[:, :, None, :] - sa[..., None] * b_t[:, :, None, :] + v_t[..., None] * k_t[:, :, None, :]
        return s, jnp.einsum('bhvk,bhk->bhv', s, r_t)
    xs = tuple(jnp.moveaxis(u.astype(jnp.float32), 1, 0) for u in (r, w, k, v, kk, b))
    s, ys = lax.scan(step, s0, xs)
    return jnp.moveaxis(ys, 0, 1).astype(dt), s


def rwkv_out(y, prep, b_rk, ln_g, ln_b):
    r, _, kd, v, _, _, g = prep
    yf = y.astype(jnp.float32)
    mu = jnp.mean(yf, axis=-1, keepdims=True)
    var = jnp.mean(jnp.square(yf - mu), axis=-1, keepdims=True)
    yn = ((yf - mu) * lax.rsqrt(var + LN_EPS)).astype(r.dtype) * ln_g + ln_b
    bonus = jnp.sum(jnp.sum(r[:, :, None] * kd * b_rk, axis=-1, keepdims=True), axis=2) * v
    out = (yn + bonus) * g.reshape(v.shape)
    return out.reshape(v.shape[0], v.shape[1], B_WIDTH)


def rwkv_bidir(pc, pl, need_ctx, b_shift, b_w0, b_w_up, b_a0, b_a_up, b_g_up, b_kk, b_ka, b_rk, b_ln_g, b_ln_b):
    prep_c = rwkv_prep(pc, b_shift, b_w0, b_w_up, b_a0, b_a_up, b_g_up, b_kk, b_ka)
    prep_l = rwkv_prep(pl, b_shift, b_w0, b_w_up, b_a0, b_a_up, b_g_up, b_kk, b_ka)
    bn = pl.shape[0]
    ys_c, ys_l = [], []
    for d in range(2):
        s0 = jnp.zeros((bn, B_HEADS, B_HEAD, B_HEAD), jnp.float32)
        y_c, s_c = rwkv7_scan(*rwkv_dir_inputs(prep_c, d), s0)
        y_l, _ = rwkv7_scan(*rwkv_dir_inputs(prep_l, d), s_c)
        if d == 1:
            y_c, y_l = y_c[:, ::-1], y_l[:, ::-1]
        ys_c.append(y_c)
        ys_l.append(y_l)
    out_l = rwkv_out(ys_l[0] + ys_l[1], prep_l, b_rk, b_ln_g, b_ln_b)
    out_c = rwkv_out(ys_c[0] + ys_c[1], prep_c, b_rk, b_ln_g, b_ln_b) if need_ctx else None
    return out_c, out_l


def mixer_ab(hc, hl, need_ctx, w_in, w_out, a_ws, a_bs, a_gv, b_shift, b_w0, b_w_up, b_a0, b_a_up,
             b_g_up, b_kk, b_ka, b_rk, b_ln_g, b_ln_b):
    pc, pl = hc @ w_in, hl @ w_in
    bc, bl = rwkv_bidir(pc, pl, need_ctx, b_shift, b_w0, b_w_up, b_a0, b_a_up, b_g_up, b_kk, b_ka,
                        b_rk, b_ln_g, b_ln_b)
    yl = jnp.concatenate([spatial_gate(pl, a_ws, a_bs, a_gv), bl], axis=-1) @ w_out
    yc = jnp.concatenate([spatial_gate(pc, a_ws, a_bs, a_gv), bc], axis=-1) @ w_out if need_ctx else None
    return yc, yl


def mlstm_prep(p, conv, conv_b, wq, wk, wv, bi, bf):
    bn, t, _ = p.shape
    xm, z = p[..., :C_WIDTH], p[..., C_WIDTH:2 * C_WIDTH]
    gates = p[..., 2 * C_WIDTH:].reshape(bn, t, 2, 2, C_HEADS)
    xcv = jax.nn.silu(dwconv1d(xm, conv) + conv_b)
    def blockdiag(u, w):
        return jnp.einsum('btgi,gio->btgo', u.reshape(bn, t, C_WIDTH // QKV_BLOCK, QKV_BLOCK), w).reshape(bn, t, C_WIDTH)
    def heads(u):
        return u.reshape(bn, t, C_HEADS, C_HEAD).transpose(0, 2, 1, 3)
    q = heads(blockdiag(xcv, wq))
    k = heads(blockdiag(xcv, wk)) * (C_HEAD ** -0.5)
    v = heads(blockdiag(xm, wv))
    logi = jnp.transpose(gates[:, :, 0] + bi, (2, 0, 3, 1))
    logf = jax.nn.log_sigmoid(jnp.transpose(gates[:, :, 1] + bf, (2, 0, 3, 1)))
    return q, k, v, logi, logf, xcv, z


def mlstm_dir_inputs(prep, d):
    q, k, v, logi, logf = prep[:5]
    seq = (q, k, v, logi[d], logf[d])
    return tuple(u[:, :, ::-1] for u in seq) if d == 1 else seq


def mlstm_chunk_scan(q, k, v, logi, logf, state):
    bn, nh, t, dh = q.shape
    nc = t // C_CHUNK
    dt = q.dtype
    tril = jnp.tril(jnp.ones((C_CHUNK, C_CHUNK), dtype=bool))
    def chunks(u):
        u = u.astype(jnp.float32)
        return jnp.moveaxis(u.reshape((bn, nh, nc, C_CHUNK) + u.shape[3:]), 2, 0)
    def step(carry, inp):
        cmat, nvec, m = carry
        qc, kc, vc, li, lf = inp
        b = jnp.cumsum(lf, axis=-1)
        logd = jnp.where(tril, b[..., :, None] - b[..., None, :] + li[..., None, :], -jnp.inf)
        inter = b + m[..., None]
        m_row = jnp.maximum(inter, jnp.max(logd, axis=-1))
        s = jnp.einsum('bhjd,bhsd->bhjs', qc, kc) * jnp.exp(logd - m_row[..., None])
        w_inter = jnp.exp(inter - m_row)
        num = jnp.einsum('bhjs,bhsv->bhjv', s, vc) + w_inter[..., None] * jnp.einsum('bhvd,bhjd->bhjv', cmat, qc)
        den = jnp.sum(s, axis=-1) + w_inter * jnp.einsum('bhd,bhjd->bhj', nvec, qc)
        h = num / jnp.maximum(jnp.abs(den), jnp.exp(-m_row))[..., None]
        b_last = b[..., -1]
        log_in = b_last[..., None] - b + li
        m_new = jnp.maximum(b_last + m, jnp.max(log_in, axis=-1))
        carry_scale = jnp.exp(b_last + m - m_new)
        kw = kc * jnp.exp(log_in - m_new[..., None])[..., None]
        cmat = carry_scale[..., None, None] * cmat + jnp.einsum('bhsv,bhsd->bhvd', vc, kw)
        nvec = carry_scale[..., None] * nvec + jnp.sum(kw, axis=-2)
        return (cmat, nvec, m_new), h
    state, hs = lax.scan(step, state, tuple(chunks(u) for u in (q, k, v, logi, logf)))
    h = jnp.moveaxis(hs, 0, 2).reshape(bn, nh, t, v.shape[-1])
    return h.astype(dt), state


def mlstm_out(h, xcv, z, c_norm, c_skip, w_out):
    bn, nh, t, dh = h.shape
    hn = rmsnorm(h.transpose(0, 2, 1, 3), c_norm).reshape(bn, t, C_WIDTH)
    return ((hn + c_skip * xcv) * jax.nn.sigmoid(z)) @ w_out


def mixer_mlstm(hc, hl, need_ctx, w_in, w_out, conv, conv_b, wq, wk, wv, bi, bf, c_norm, c_skip):
    prep_c = mlstm_prep(hc @ w_in, conv, conv_b, wq, wk, wv, bi, bf)
    prep_l = mlstm_prep(hl @ w_in, conv, conv_b, wq, wk, wv, bi, bf)
    bn = hl.shape[0]
    hs_c, hs_l = [], []
    for d in range(2):
        init = (jnp.zeros((bn, C_HEADS, C_HEAD, C_HEAD), jnp.float32),
                jnp.zeros((bn, C_HEADS, C_HEAD), jnp.float32),
                jnp.zeros((bn, C_HEADS), jnp.float32))
        h_c, st = mlstm_chunk_scan(*mlstm_dir_inputs(prep_c, d), init)
        h_l, _ = mlstm_chunk_scan(*mlstm_dir_inputs(prep_l, d), st)
        if d == 1:
            h_c, h_l = h_c[:, :, ::-1], h_l[:, :, ::-1]
        hs_c.append(h_c)
        hs_l.append(h_l)
    yl = mlstm_out(hs_l[0] + hs_l[1], prep_l[5], prep_l[6], c_norm, c_skip, w_out)
    yc = mlstm_out(hs_c[0] + hs_c[1], prep_c[5], prep_c[6], c_norm, c_skip, w_out) if need_ctx else None
    return yc, yl


def setup_inputs(seed: int = 0) -> dict:
    key = jax.random.key(seed)
    ks = iter(jax.random.split(key, 64))
    def nrm(shape, s):
        return jax.random.normal(next(ks), shape, jnp.float32) * s
    D = D_MODEL
    return {
        'x': nrm((BATCH, SEQ, D), 1.0),
        'c': nrm((BATCH, D), 1.0),
        'ctx': nrm((BATCH, CTX_LEN, D), 1.0),
        'c_ctx': nrm((D,), 1.0),
        'ada_w': nrm((DEPTH, D, 6 * D), D ** -0.5),
        'ada_b': nrm((DEPTH, 6 * D), 0.02),
        'norm_mix_pre': 1.0 + nrm((DEPTH, D), 0.05),
        'norm_mix_post': 1.0 + nrm((DEPTH, D), 0.05),
        'norm_ffn_pre': 1.0 + nrm((DEPTH, D), 0.05),
        'norm_ffn_post': 1.0 + nrm((DEPTH, D), 0.05),
        'ffn_up': nrm((DEPTH, D, 2 * D_FF), D ** -0.5),
        'ffn_conv': nrm((DEPTH, 3, 3, D_FF), 1.0 / 3.0),
        'ffn_conv_b': nrm((DEPTH, D_FF), 0.02),
        'ffn_down': nrm((DEPTH, D_FF, D), D_FF ** -0.5),
        'ab_w_in': nrm((N_EVEN, D, AB_IN), D ** -0.5),
        'ab_w_out': nrm((N_EVEN, MIX_W, D), MIX_W ** -0.5),
        'a_ws': nrm((N_EVEN, A_GROUPS, CHUNK, CHUNK), CHUNK ** -0.5),
        'a_bs': 1.0 + nrm((N_EVEN, A_GROUPS, CHUNK), 0.1),
        'a_gv': 1.0 + nrm((N_EVEN, A_GROUPS, A_GDIM), 0.05),
        'b_shift': nrm((N_EVEN, 3, 3 * B_WIDTH), 0.5),
        'b_w0': jnp.linspace(-6.0, -1.0, B_WIDTH, dtype=jnp.float32) + nrm((N_EVEN, 2, B_WIDTH), 0.1),
        'b_w_up': nrm((N_EVEN, 2, DECAY_LORA, B_WIDTH), 0.5 * DECAY_LORA ** -0.5),
        'b_a0': nrm((N_EVEN, 2, B_WIDTH), 0.1),
        'b_a_up': nrm((N_EVEN, 2, AAA_LORA, B_WIDTH), AAA_LORA ** -0.5),
        'b_g_up': nrm((N_EVEN, GATE_LORA, B_WIDTH), GATE_LORA ** -0.5),
        'b_kk': 0.85 + nrm((N_EVEN, B_WIDTH), 0.05),
        'b_ka': 1.0 + nrm((N_EVEN, B_WIDTH), 0.05),
        'b_rk': nrm((N_EVEN, B_HEADS, B_HEAD), 0.1),
        'b_ln_g': 1.0 + nrm((N_EVEN, B_HEADS, B_HEAD), 0.05),
        'b_ln_b': nrm((N_EVEN, B_HEADS, B_HEAD), 0.02),
        'c_w_in': nrm((N_ODD, D, C_IN), D ** -0.5),
        'c_w_out': nrm((N_ODD, C_WIDTH, D), C_WIDTH ** -0.5),
        'c_conv': nrm((N_ODD, 3, C_WIDTH), 0.5),
        'c_conv_b': nrm((N_ODD, C_WIDTH), 0.02),
        'c_wq': nrm((N_ODD, C_WIDTH // QKV_BLOCK, QKV_BLOCK, QKV_BLOCK), QKV_BLOCK ** -0.5),
        'c_wk': nrm((N_ODD, C_WIDTH // QKV_BLOCK, QKV_BLOCK, QKV_BLOCK), QKV_BLOCK ** -0.5),
        'c_wv': nrm((N_ODD, C_WIDTH // QKV_BLOCK, QKV_BLOCK, QKV_BLOCK), QKV_BLOCK ** -0.5),
        'c_bi': nrm((N_ODD, 2, C_HEADS), 0.1),
        'c_bf': jnp.linspace(3.0, 6.0, C_HEADS, dtype=jnp.float32) + nrm((N_ODD, 2, C_HEADS), 0.1),
        'c_norm': 1.0 + nrm((N_ODD, C_HEADS, C_HEAD), 0.05),
        'c_skip': 1.0 + nrm((N_ODD, C_WIDTH), 0.05),
    }


def reference(x, c, ctx, c_ctx, ada_w, ada_b, norm_mix_pre, norm_mix_post, norm_ffn_pre, norm_ffn_post,
              ffn_up, ffn_conv, ffn_conv_b, ffn_down, ab_w_in, ab_w_out, a_ws, a_bs, a_gv, b_shift, b_w0,
              b_w_up, b_a0, b_a_up, b_g_up, b_kk, b_ka, b_rk, b_ln_g, b_ln_b, c_w_in, c_w_out, c_conv,
              c_conv_b, c_wq, c_wk, c_wv, c_bi, c_bf, c_norm, c_skip):
    rows = x.shape[1] // GRID_W
    xl, xc = x, ctx
    for layer in range(DEPTH):
        need_ctx = layer < DEPTH - 1
        i = layer // 2
        ml = ada_mod(c, ada_w[layer], ada_b[layer])
        mc = ada_mod(c_ctx, ada_w[layer], ada_b[layer])
        hl = modulate(rmsnorm(xl, norm_mix_pre[layer]), ml[0], ml[1])
        hc = modulate(rmsnorm(xc, norm_mix_pre[layer]), mc[0], mc[1])
        if layer % 2 == 0:
            yc, yl = mixer_ab(hc, hl, need_ctx, ab_w_in[i], ab_w_out[i], a_ws[i], a_bs[i], a_gv[i],
                              b_shift[i], b_w0[i], b_w_up[i], b_a0[i], b_a_up[i], b_g_up[i], b_kk[i],
                              b_ka[i], b_rk[i], b_ln_g[i], b_ln_b[i])
        else:
            yc, yl = mixer_mlstm(hc, hl, need_ctx, c_w_in[i], c_w_out[i], c_conv[i], c_conv_b[i],
                                 c_wq[i], c_wk[i], c_wv[i], c_bi[i], c_bf[i], c_norm[i], c_skip[i])
        xl = xl + ml[2] * rmsnorm(yl, norm_mix_post[layer])
        hl = modulate(rmsnorm(xl, norm_ffn_pre[layer]), ml[3], ml[4])
        xl = xl + ml[5] * rmsnorm(conv_ffn(hl, ffn_up[layer], ffn_conv[layer], ffn_conv_b[layer],
                                           ffn_down[layer], rows), norm_ffn_post[layer])
        if need_ctx:
            xc = xc + mc[2] * rmsnorm(yc, norm_mix_post[layer])
            hc = modulate(rmsnorm(xc, norm_ffn_pre[layer]), mc[3], mc[4])
            xc = xc + mc[5] * rmsnorm(conv_ffn(hc, ffn_up[layer], ffn_conv[layer], ffn_conv_b[layer],
                                               ffn_down[layer], None), norm_ffn_post[layer])
    return xl
```

```cpp
#include <hip/hip_runtime.h>
#include <cstdio>
#include <cstdint>
namespace pg8 {
#define PG8_LAS __attribute__((address_space(3)))
typedef unsigned short bf16_t;
typedef short bf16x8 __attribute__((ext_vector_type(8)));
typedef float f32x4 __attribute__((ext_vector_type(4)));
typedef unsigned u32x4 __attribute__((ext_vector_type(4)));
constexpr int BM = 256, BK = 64, HALF = 128, HTB = HALF * BK * 2  , STAGE_BYTES = 8 * HTB, NXCD = 8, WGM = 8;

__host__ __device__ __forceinline__ int lds_byte(int r, int c) { const int st = (r >> 4) * 2 + (c >> 5), rr = r & 15, cc = c & 31, ob = rr * 64 + cc * 2; return st * 1024 + (ob ^ (((ob >> 9) & 1) << 5)); }
__host__ __device__ __forceinline__ void stage_rc(int b, int& R, int& C) { const int st = b / 1024, sb = b % 1024, swz = sb ^ (((sb >> 9) & 1) << 5); R = (st >> 1) * 16 + swz / 64; C = (st & 1) * 32 + (swz % 64) / 2; }
__host__ __device__ __forceinline__ int perm32(int rho) { const int n = rho >> 4, i = rho & 15; return 8 * (i >> 2) + 4 * n + (i & 3); }

struct Unit { int pm, pn; };
struct Gemm { const bf16_t* A; const bf16_t* Bt; int M, N, K; };

struct StaticOrder {
    int nM, nN, nwg, G, c;
    __host__ __device__ void init(int M, int N, int G_, int c_) { nM = M / BM; nN = N / BM; nwg = nM * nN; G = G_; c = c_; }
    __host__ __device__ bool next(int i, Unit& u) const {
        const long L = (long)i * G + c; if (L >= nwg) return false;
        int wgid = (int)L; { const int q = nwg / NXCD, r = nwg % NXCD, xcd = wgid % NXCD, off = wgid / NXCD; wgid = (xcd < r ? xcd * (q + 1) : r * (q + 1) + (xcd - r) * q) + off; }
        const int nig = WGM * nN, gid = wgid / nig, fm = gid * WGM, gsz = (nM - fm) < WGM ? (nM - fm) : WGM;
        u.pm = fm + ((wgid % nig) % gsz); u.pn = (wgid % nig) / gsz; return true;
    }
    __device__ __forceinline__ void a_ready(const Unit&) const {}
    __device__ __forceinline__ void done(const Unit&) const {}
};

template <class Epi, class Sched, bool ALIGN_EPI = false, bool SP2 = false>
__device__ __forceinline__ void gemm_phase(PG8_LAS unsigned char* lds, const Gemm g, const Sched& S, const Epi& E) {
    const int tid = threadIdx.x, wid = __builtin_amdgcn_readfirstlane(tid >> 6), lane = tid & 63, wr = wid >> 2, wc = wid & 3, fr = lane & 15, fq = lane >> 4;
    const int K = g.K, nt = K / BK;
    unsigned voffA[2], voffB[2];
#pragma unroll
    for (int i = 0; i < 2; ++i) { int R, C; stage_rc(tid * 16 + i * 8192, R, C); const int Rb = Epi::PERM ? ((R & ~31) + perm32(R & 31)) : R;
        voffA[i] = (unsigned)(R * K + C) * 2u; voffB[i] = (unsigned)(Rb * K + C) * 2u; }
    const size_t kstep = (size_t)(BK * 2);
    const size_t hstep = (size_t)HALF * K * 2;
    const size_t tstep = 2 * hstep;
    const unsigned ldsw = (unsigned)wid * 1024u;
    const int aoff = lds_byte(wr * 64 + fr, fq * 8), boff = lds_byte(wc * 32 + fr, fq * 8);
#define PG8_SA(b, h) (((b) * 2 + (h)) * HTB)
#define PG8_SB(b, h) ((4 + (b) * 2 + (h)) * HTB)
#define PG8_STAGE(bufoff, gbase, voff) do { _Pragma("unroll") for (int _i = 0; _i < 2; ++_i) \
        __builtin_amdgcn_global_load_lds((const unsigned*)((const char*)(gbase) + (voff)[_i]), (PG8_LAS unsigned*)(lds + (bufoff) + ldsw + _i * 8192), 16, 0, 0); } while (0)
#define PG8_LDA(dst, b, h) do { _Pragma("unroll") for (int m = 0; m < 4; ++m) _Pragma("unroll") for (int k = 0; k < 2; ++k) dst[m][k] = *(const PG8_LAS bf16x8*)(lds + PG8_SA(b, h) + aoff + m * 2048 + k * 1024); } while (0)
#define PG8_LDB(dst, b, h) do { _Pragma("unroll") for (int n = 0; n < 2; ++n) _Pragma("unroll") for (int k = 0; k < 2; ++k) dst[n][k] = *(const PG8_LAS bf16x8*)(lds + PG8_SB(b, h) + boff + n * 2048 + k * 1024); } while (0)
#define PG8_MMA(ai, bj, At, Bt) do { __builtin_amdgcn_s_setprio(1); _Pragma("unroll") for (int m = 0; m < 4; ++m) _Pragma("unroll") for (int n = 0; n < 2; ++n) _Pragma("unroll") for (int k = 0; k < 2; ++k) \
        acc[ai][bj][m][n] = __builtin_amdgcn_mfma_f32_16x16x32_bf16(Bt[n][k], At[m][k], acc[ai][bj][m][n], 0, 0, 0); __builtin_amdgcn_s_setprio(0); } while (0)
#define PG8_WAIT_V(n) asm volatile("s_waitcnt vmcnt(" #n ")" ::: "memory")
#define PG8_WAIT_L(n) asm volatile("s_waitcnt lgkmcnt(" #n ")" ::: "memory")
#define PG8_BAR __builtin_amdgcn_s_barrier()
#define PG8_SCHED __builtin_amdgcn_sched_barrier(0)
    Unit cur, nxt; int ui = 0;
    if (!S.next(0, cur)) return;
    f32x4 acc[2][2][4][2];
#pragma unroll
    for (int a = 0; a < 2; ++a)
#pragma unroll
        for (int b = 0; b < 2; ++b)
#pragma unroll
            for (int m = 0; m < 4; ++m)
#pragma unroll
                for (int n = 0; n < 2; ++n) acc[a][b][m][n] = (f32x4){0.f, 0.f, 0.f, 0.f};
    bf16x8 At[4][2], B0[2][2], B1[2][2];
    const char* cA = (const char*)g.A + (size_t)cur.pm * tstep; const char* cB = (const char*)g.Bt + (size_t)cur.pn * tstep;
    S.a_ready(cur);
    if constexpr (SP2) {
        PG8_STAGE(PG8_SB(0, 0), cB, voffB); PG8_STAGE(PG8_SB(0, 1), cB + hstep, voffB); PG8_STAGE(PG8_SA(0, 0), cA, voffA); PG8_STAGE(PG8_SA(0, 1), cA + hstep, voffA);
        if (wr == 1) PG8_BAR;
        PG8_WAIT_V(2); PG8_BAR;
        PG8_STAGE(PG8_SB(1, 0), cB + kstep, voffB); PG8_STAGE(PG8_SA(1, 0), cA + kstep, voffA); PG8_STAGE(PG8_SB(1, 1), cB + hstep + kstep, voffB);
        PG8_WAIT_V(6); PG8_BAR;
    } else {
        PG8_STAGE(PG8_SB(0, 0), cB, voffB); PG8_STAGE(PG8_SA(0, 0), cA, voffA); PG8_STAGE(PG8_SB(0, 1), cB + hstep, voffB); PG8_STAGE(PG8_SA(0, 1), cA + hstep, voffA);
        if (wr == 1) PG8_BAR;
        PG8_WAIT_V(4); PG8_BAR;
        PG8_STAGE(PG8_SB(1, 0), cB + kstep, voffB); PG8_STAGE(PG8_SA(1, 0), cA + kstep, voffA); PG8_STAGE(PG8_SB(1, 1), cB + hstep + kstep, voffB);
        PG8_WAIT_V(6); PG8_BAR;
    }
    for (;;) {
        const bool has_next = S.next(ui + 1, nxt);
        const char* nA = has_next ? (const char*)g.A + (size_t)nxt.pm * tstep : cA; const char* nB = has_next ? (const char*)g.Bt + (size_t)nxt.pn * tstep : cB;
        for (int t = 0; t < nt; t += 2) {
            const bool last = (t == nt - 2);
            const char* a1 = cA + (size_t)(t + 1) * kstep;
            const char* a2 = last ? nA : cA + (size_t)(t + 2) * kstep; const char* b2 = last ? nB : cB + (size_t)(t + 2) * kstep;
            const char* a3 = a2 + kstep; const char* b3 = b2 + kstep;
            if (last && has_next) S.a_ready(nxt);
            if constexpr (SP2) {
            PG8_LDB(B0, 0, 0); PG8_LDB(B1, 0, 1); PG8_SCHED; PG8_LDA(At, 0, 0); PG8_STAGE(PG8_SA(1, 1), a1 + hstep, voffA);
            PG8_WAIT_V(8); PG8_WAIT_L(0); PG8_BAR; PG8_MMA(0, 0, At, B0); PG8_MMA(0, 1, At, B1); PG8_BAR; PG8_SCHED;
            PG8_LDA(At, 0, 1); PG8_STAGE(PG8_SB(0, 0), b2, voffB); PG8_STAGE(PG8_SB(0, 1), b2 + hstep, voffB); PG8_STAGE(PG8_SA(0, 0), a2, voffA);
            PG8_WAIT_V(8); PG8_WAIT_L(0); PG8_BAR; PG8_MMA(1, 0, At, B0); PG8_MMA(1, 1, At, B1); PG8_BAR; PG8_SCHED;
            PG8_LDB(B0, 1, 0); PG8_LDB(B1, 1, 1); PG8_SCHED; PG8_LDA(At, 1, 0); PG8_STAGE(PG8_SA(0, 1), a2 + hstep, voffA);
            PG8_WAIT_V(8); PG8_WAIT_L(0); PG8_BAR; PG8_MMA(0, 0, At, B0); PG8_MMA(0, 1, At, B1); PG8_BAR; PG8_SCHED;
            PG8_LDA(At, 1, 1); PG8_STAGE(PG8_SB(1, 0), b3, voffB); PG8_STAGE(PG8_SB(1, 1), b3 + hstep, voffB); PG8_STAGE(PG8_SA(1, 0), a3, voffA);
            PG8_WAIT_V(8); PG8_WAIT_L(0); PG8_BAR; PG8_MMA(1, 0, At, B0); PG8_MMA(1, 1, At, B1); PG8_BAR; PG8_SCHED;
            } else {
            PG8_LDB(B0, 0, 0); PG8_SCHED; PG8_LDA(At, 0, 0); PG8_STAGE(PG8_SA(1, 1), a1 + hstep, voffA);
            PG8_WAIT_L(8); PG8_BAR; PG8_WAIT_L(0); PG8_MMA(0, 0, At, B0); PG8_BAR; PG8_SCHED;
            PG8_LDB(B1, 0, 1); PG8_STAGE(PG8_SB(0, 0), b2, voffB);
            PG8_BAR; PG8_WAIT_L(0); PG8_MMA(0, 1, At, B1); PG8_BAR;
            PG8_LDA(At, 0, 1); PG8_STAGE(PG8_SA(0, 0), a2, voffA);
            PG8_BAR; PG8_WAIT_L(0); PG8_MMA(1, 0, At, B0); PG8_BAR; PG8_SCHED;
            PG8_STAGE(PG8_SB(0, 1), b2 + hstep, voffB);
            PG8_WAIT_V(6); PG8_BAR; PG8_MMA(1, 1, At, B1); PG8_BAR;
            PG8_LDB(B0, 1, 0); PG8_SCHED; PG8_LDA(At, 1, 0); PG8_STAGE(PG8_SA(0, 1), a2 + hstep, voffA);
            PG8_WAIT_L(8); PG8_BAR; PG8_WAIT_L(0); PG8_MMA(0, 0, At, B0); PG8_BAR; PG8_SCHED;
            PG8_LDB(B1, 1, 1); PG8_STAGE(PG8_SB(1, 0), b3, voffB);
            PG8_BAR; PG8_WAIT_L(0); PG8_MMA(0, 1, At, B1); PG8_BAR;
            PG8_LDA(At, 1, 1); PG8_STAGE(PG8_SA(1, 0), a3, voffA);
            PG8_BAR; PG8_WAIT_L(0); PG8_MMA(1, 0, At, B0); PG8_BAR; PG8_SCHED;
            PG8_STAGE(PG8_SB(1, 1), b3 + hstep, voffB);
            PG8_WAIT_V(6); PG8_BAR; PG8_MMA(1, 1, At, B1); PG8_BAR;
            }
        }
        if constexpr (ALIGN_EPI) { if (wr == 0) PG8_BAR; }
        if constexpr (!Epi::AFTER_DRAIN) { E(acc, cur, wr, wc, fr, fq); S.done(cur); }
        if (!has_next) break;
#pragma unroll
        for (int a = 0; a < 2; ++a)
#pragma unroll
            for (int b = 0; b < 2; ++b)
#pragma unroll
                for (int m = 0; m < 4; ++m)
#pragma unroll
                    for (int n = 0; n < 2; ++n) acc[a][b][m][n] = (f32x4){0.f, 0.f, 0.f, 0.f};
        cur = nxt; cA = nA; cB = nB; ++ui;
        if constexpr (ALIGN_EPI) { if (wr == 1) PG8_BAR; }
    }
    PG8_WAIT_V(0);
    if constexpr (!ALIGN_EPI) { if (wr == 0) PG8_BAR; }
    PG8_BAR;
    if constexpr (Epi::AFTER_DRAIN) { E.fused(acc, cur, wr, wc, fr, fq, lds, wid, lane); S.done(cur); }
#undef PG8_SA
#undef PG8_SB
#undef PG8_STAGE
#undef PG8_LDA
#undef PG8_LDB
#undef PG8_MMA
#undef PG8_WAIT_V
#undef PG8_WAIT_L
#undef PG8_BAR
#undef PG8_SCHED
}
}

#include <hip/hip_cooperative_groups.h>
namespace cg = cooperative_groups;

#define LAS __attribute__((address_space(3)))
typedef unsigned short bf16_t;
typedef float f32x4 __attribute__((ext_vector_type(4)));
typedef float f32x2 __attribute__((ext_vector_type(2)));
typedef unsigned u32x4 __attribute__((ext_vector_type(4)));
typedef unsigned u32x2 __attribute__((ext_vector_type(2)));
typedef short bf16x8 __attribute__((ext_vector_type(8)));

constexpr int DM = 1024, NB = 4, TL = 8192, TC = 256;
constexpr int ML = NB * TL;
constexpr int MC = NB * TC;
constexpr int MR = ML + MC;
constexpr int DFF = 2816;
constexpr float EPS = 1e-6f, LN_EPS = 64e-5f;
constexpr int NWAVES = 8, NTHR = 512;
constexpr int LDS_BYTES = 147456;
constexpr int PTR_TBL_OFF = 146432;

constexpr size_t MiB = 1u << 20;
constexpr size_t OFF_MODS = 0;
constexpr size_t OFF_CHS = 512 * 1024;
constexpr size_t OFF_XC = 1 * MiB;
constexpr size_t OFF_GATES = 5 * MiB;
constexpr size_t OFF_E = 8 * MiB;
constexpr size_t EB_STRIDE = 32 * 66 * 128 * 4;
constexpr size_t OFF_WIN1 = 12 * MiB;
constexpr size_t OFF_WOUT1 = 17 * MiB;
constexpr size_t OFF_WUP1 = 19 * MiB;
constexpr size_t OFF_WDN1 = 30 * MiB;
constexpr size_t OFF_WL = 36 * MiB;
constexpr size_t OFF_WIN0 = 38 * MiB;
constexpr size_t OFF_WOUT0 = 44 * MiB;
constexpr size_t OFF_WUP0 = 46 * MiB;
constexpr size_t OFF_WDN0 = 57 * MiB;
constexpr size_t OFF_RA = 63 * MiB;
constexpr size_t OFF_RB = 129 * MiB;
constexpr size_t OFF_RC = 195 * MiB;
constexpr size_t OFF_RD = 294 * MiB;
constexpr size_t OFF_RE = 319 * MiB;
constexpr size_t OFF_YF0 = 129 * MiB;
constexpr size_t OFF_UA0 = 129 * MiB;
constexpr size_t OFF_UB0 = 311 * MiB;
constexpr size_t OFF_XM = 36 * MiB;
constexpr size_t OFF_SZ = 102 * MiB;
constexpr size_t OFF_Q = 168 * MiB;
constexpr size_t OFF_K = 234 * MiB;
constexpr size_t OFF_S = 300 * MiB;
constexpr size_t OFF_H1 = 300 * MiB;
constexpr size_t OFF_HO0 = 366 * MiB;
constexpr size_t OFF_HO1 = 430 * MiB;
constexpr size_t OFF_MIX1 = 168 * MiB;
constexpr size_t OFF_YF1 = 36 * MiB;
constexpr size_t OFF_H1F = 436 * MiB;
constexpr size_t OFF_UA1 = 36 * MiB;
constexpr size_t OFF_UB1 = 212 * MiB;
constexpr size_t WS_NEED = 502 * MiB;

__device__ __forceinline__ float bf_lo(unsigned w) { return __uint_as_float(w << 16); }
__device__ __forceinline__ float bf_hi(unsigned w) { return __uint_as_float(w & 0xffff0000u); }
__device__ __forceinline__ float bf2f(bf16_t v) { return __uint_as_float(((unsigned)v) << 16); }
typedef __bf16 bf16x2_t __attribute__((ext_vector_type(2)));
__device__ __forceinline__ unsigned pkbf(float lo, float hi) { const f32x2 v = {lo, hi}; return __builtin_bit_cast(unsigned, __builtin_convertvector(v, bf16x2_t)); }
__device__ __forceinline__ bf16_t f2bf(float f) { return (bf16_t)(pkbf(f, 0.f) & 0xffffu); }
__device__ __forceinline__ void unpack8(const u32x4 w, float* o) {
    o[0] = bf_lo(w.x); o[1] = bf_hi(w.x); o[2] = bf_lo(w.y); o[3] = bf_hi(w.y);
    o[4] = bf_lo(w.z); o[5] = bf_hi(w.z); o[6] = bf_lo(w.w); o[7] = bf_hi(w.w);
}
__device__ __forceinline__ u32x4 pack8(const float* o) {
    u32x4 w; w.x = pkbf(o[0], o[1]); w.y = pkbf(o[2], o[3]); w.z = pkbf(o[4], o[5]); w.w = pkbf(o[6], o[7]); return w;
}
__device__ __forceinline__ float sigmoidf_(float x) { return 1.0f / (1.0f + __expf(-x)); }
__device__ __forceinline__ float tanhf_(float x) { return 1.0f - 2.0f / (__expf(2.0f * x) + 1.0f); }
__device__ __forceinline__ float gelu_tanh(float x) { const float u = 0.7978845608f * (x + 0.044715f * x * x * x); return 0.5f * x * (1.0f + tanhf_(u)); }
__device__ __forceinline__ float siluf_(float x) { return x * sigmoidf_(x); }
__device__ __forceinline__ float softplusf_(float x) { return x > 20.f ? x : log1pf(__expf(x)); }
__device__ __forceinline__ float logsigmoidf_(float x) { return fminf(x, 0.f) - log1pf(__expf(-fabsf(x))); }

template <int CTRL> __device__ __forceinline__ float dppf(float v) {
    return __builtin_bit_cast(float, __builtin_amdgcn_update_dpp(0, __builtin_bit_cast(int, v), CTRL, 0xF, 0xF, true));
}
__device__ __forceinline__ float red4(float v) { v += dppf<0xB1>(v); v += dppf<0x4E>(v); return v; }
__device__ __forceinline__ float red8(float v) { v = red4(v); v += dppf<0x141>(v); return v; }
__device__ __forceinline__ float red16(float v) { v = red8(v); v += dppf<0x140>(v); return v; }
__device__ __forceinline__ float wave_sum(float v) {
#pragma unroll
    for (int o = 1; o < 64; o <<= 1) v += __shfl_xor(v, o);
    return v;
}

struct Frame {
    LAS unsigned char* lds;
    int tid, lane, wave, vcu, G;
    float* out;
    unsigned char* ws;
    __device__ __forceinline__ const float* inp(int i) const {
        const LAS unsigned* t = (const LAS unsigned*)(lds + PTR_TBL_OFF) + 2 * i;
        const unsigned lo = __builtin_amdgcn_readfirstlane(t[0]), hi = __builtin_amdgcn_readfirstlane(t[1]);
        return (const float*)(((unsigned long long)hi << 32) | lo);
    }
};

__device__ __forceinline__ int row_mv(int r) { return r < ML ? (r >> 13) : 4; }
__device__ __forceinline__ void row_nbr(int r, bool& hp, bool& hn) {
    if (r < ML) { const int t = r & (TL - 1); hp = t > 0; hn = t < TL - 1; }
    else { const int t = (r - ML) & (TC - 1); hp = t > 0; hn = t < TC - 1; }
}

enum { ACT_NONE = 0, ACT_GELU = 1, ACT_TANH = 2, ACT_SIG = 3, ACT_LW = 4, ACT_SIGB = 5, ACT_SKIP = 6, ACT_GATES = 7 };
enum { EM_IN0 = 0, EM_LORA = 1, EM_UP = 2, EM_IN1 = 3 };

template <int MODE> struct EpiSeg {
    static constexpr bool PERM = true, AFTER_DRAIN = false;
    unsigned char* ws; const float* b0; const float* b1;
    size_t offA, offB;
    int ldu;
    __device__ __forceinline__ void seg(int hc, bf16_t*& p, int& ld, int& c0, int& act, const float*& bias, float& scl) const {
        bias = nullptr; scl = 1.0f;
        if (MODE == EM_IN0) {
            if (hc < 8) { p = (bf16_t*)(ws + OFF_RB); ld = 1024; c0 = hc * 128; act = ACT_GELU; }
            else if (hc < 20) { p = (bf16_t*)(ws + OFF_RC); ld = 1536; c0 = (hc - 8) * 128; act = ACT_NONE; }
            else if (hc == 20) { p = (bf16_t*)(ws + OFF_RD); ld = 384; c0 = 0; act = ACT_TANH; }
            else if (hc == 21) { p = (bf16_t*)(ws + OFF_RD); ld = 384; c0 = 128; act = ACT_NONE; }
            else if (hc == 22) { p = (bf16_t*)(ws + OFF_RD); ld = 384; c0 = 256; act = ACT_SIG; }
            else { p = nullptr; ld = 0; c0 = 0; act = ACT_SKIP; }
        } else if (MODE == EM_LORA) {
            const int a = hc >> 2;
            p = (bf16_t*)(ws + OFF_RE) + (size_t)a * MR * 512; ld = 512; c0 = (hc & 3) * 128;
            if (a < 2) { act = ACT_SIGB; scl = -0.6065306597f; bias = b0 + a * 512 + c0; }
            else if (a < 4) { act = ACT_SIGB; bias = b1 + (a - 2) * 512 + c0; }
            else act = ACT_NONE;
        } else if (MODE == EM_UP) {
            if (hc < 22) { p = (bf16_t*)(ws + offA); c0 = hc * 128; } else { p = (bf16_t*)(ws + offB); c0 = (hc - 22) * 128; }
            ld = DFF; act = ACT_NONE;
        } else {
            if (hc < 8) { p = (bf16_t*)(ws + OFF_XM); ld = 1024; c0 = hc * 128; act = ACT_NONE; }
            else if (hc < 16) { p = (bf16_t*)(ws + OFF_SZ); ld = 1024; c0 = (hc - 8) * 128; act = ACT_SIG; }
            else if (hc == 16) { p = nullptr; ld = 0; c0 = 0; act = ACT_GATES; }
            else { p = nullptr; ld = 0; c0 = 0; act = ACT_SKIP; }
        }
    }
    template <int ACT, int BJ> __device__ __forceinline__ void emit(const f32x4 (&acc)[2][2][4][2], bf16_t* p, int ld, int c0, const float* bias, float scl, int row0, int cl) const {
        float bv[8];
#pragma unroll
        for (int j = 0; j < 8; ++j) bv[j] = (ACT == ACT_SIGB) ? bias[cl + j] : 0.f;
#pragma unroll
        for (int ai = 0; ai < 2; ++ai)
#pragma unroll
            for (int m = 0; m < 4; ++m) {
                float v[8];
#pragma unroll
                for (int j = 0; j < 4; ++j) { v[j] = acc[ai][BJ][m][0][j]; v[4 + j] = acc[ai][BJ][m][1][j]; }
#pragma unroll
                for (int j = 0; j < 8; ++j) {
                    float x = v[j];
                    if (ACT == ACT_GELU) x = gelu_tanh(x);
                    else if (ACT == ACT_TANH) x = tanhf_(x);
                    else if (ACT == ACT_SIG) x = sigmoidf_(x);
                    else if (ACT == ACT_SIGB) x = scl * sigmoidf_(x + bv[j]);
                    v[j] = x;
                }
                *(u32x4*)(p + (size_t)(row0 + ai * 128 + m * 16) * ld + c0 + cl) = pack8(v);
            }
    }
    template <int BJ> __device__ __forceinline__ void half(const f32x4 (&acc)[2][2][4][2], const pg8::Unit& u, int wr, int wc, int fr, int fq) const {
        const int row0 = u.pm * 256 + wr * 64 + fr;
        bf16_t* p; int ld, c0, act; const float* bias; float scl;
        seg(u.pn * 2 + BJ, p, ld, c0, act, bias, scl);
        const int cl = wc * 32 + 8 * fq;
        if (act == ACT_GATES) {
            if (cl < 16) {
                float* gp = (float*)(ws + OFF_GATES);
#pragma unroll
                for (int ai = 0; ai < 2; ++ai)
#pragma unroll
                    for (int m = 0; m < 4; ++m) {
                        float* rp = gp + (size_t)(row0 + ai * 128 + m * 16) * 16 + cl;
                        *(f32x4*)rp = acc[ai][BJ][m][0]; *(f32x4*)(rp + 4) = acc[ai][BJ][m][1];
                    }
            }
        }
        else if (act == ACT_NONE) emit<ACT_NONE, BJ>(acc, p, ld, c0, bias, scl, row0, cl);
        else if (act == ACT_GELU) emit<ACT_GELU, BJ>(acc, p, ld, c0, bias, scl, row0, cl);
        else if (act == ACT_TANH) emit<ACT_TANH, BJ>(acc, p, ld, c0, bias, scl, row0, cl);
        else if (act == ACT_SIG) emit<ACT_SIG, BJ>(acc, p, ld, c0, bias, scl, row0, cl);
        else if (act == ACT_SIGB) emit<ACT_SIGB, BJ>(acc, p, ld, c0, bias, scl, row0, cl);
    }
    __device__ __forceinline__ void operator()(const f32x4 (&acc)[2][2][4][2], const pg8::Unit& u, int wr, int wc, int fr, int fq) const {
        half<0>(acc, u, wr, wc, fr, fq);
        half<1>(acc, u, wr, wc, fr, fq);
    }
};

struct EpiF32 {
    static constexpr bool PERM = false, AFTER_DRAIN = false;
    float* C; int ldc;
    __device__ __forceinline__ void operator()(const f32x4 (&acc)[2][2][4][2], const pg8::Unit& u, int wr, int wc, int fr, int fq) const {
        const int row0 = u.pm * 256 + wr * 64 + fr, col0 = u.pn * 256 + wc * 32 + 4 * fq;
#pragma unroll
        for (int ai = 0; ai < 2; ++ai)
#pragma unroll
            for (int m = 0; m < 4; ++m) { float* rowp = C + (size_t)(row0 + ai * 128 + m * 16) * ldc + col0;
#pragma unroll
                for (int bj = 0; bj < 2; ++bj)
#pragma unroll
                    for (int n = 0; n < 2; ++n) *(f32x4*)(rowp + bj * 128 + n * 16) = acc[ai][bj][m][n]; }
    }
};

template <class Epi> __device__ __forceinline__ void run_gemm(Frame& F, const bf16_t* A, const bf16_t* Bt, int M, int N, int K, const Epi& E) {
    asm volatile("" : "+s"(M), "+s"(N), "+s"(K));
    pg8::Gemm g{A, Bt, M, N, K}; pg8::StaticOrder S; S.init(M, N, F.G, (int)blockIdx.x);
    pg8::gemm_phase<Epi, pg8::StaticOrder, true, true>(F.lds, g, S, E);
}

__device__ __forceinline__ void p0_transpose_item(const float* W, int ldw, int K, bf16_t* WT, LAS float* scr, int kb, int nb, int lane) {
    const int k0 = 64 * kb, n0 = 32 * nb;
#pragma unroll 8
    for (int i = 0; i < 32; ++i) { const int kk = 2 * i + (lane >> 5); scr[kk * 33 + (lane & 31)] = W[(size_t)(k0 + kk) * ldw + n0 + (lane & 31)]; }
    asm volatile("s_waitcnt lgkmcnt(0)" ::: "memory");
    const int c = lane & 7;
#pragma unroll
    for (int j = 0; j < 4; ++j) { const int n = (lane >> 3) + 8 * j; const LAS float* s = scr + (8 * c) * 33 + n;
        u32x4 o; o.x = pkbf(s[0 * 33], s[1 * 33]); o.y = pkbf(s[2 * 33], s[3 * 33]); o.z = pkbf(s[4 * 33], s[5 * 33]); o.w = pkbf(s[6 * 33], s[7 * 33]);
        *(u32x4*)(WT + (size_t)(n0 + n) * K + k0 + 8 * c) = o; }
    asm volatile("s_waitcnt lgkmcnt(0)" ::: "memory");
}

__device__ __forceinline__ void phase_prologue(Frame& F) {
    unsigned char* ws = F.ws;
    {
        LAS float* S = (LAS float*)F.lds;
        LAS float* red = (LAS float*)(F.lds + 20480);
        for (int i = F.tid; i < 5 * 1024; i += NTHR) { const int v = i >> 10, k = i & 1023; const float x = v < 4 ? F.inp(1)[v * 1024 + k] : F.inp(3)[k]; S[i] = siluf_(x); }
        __syncthreads();
        for (int item = blockIdx.x; item < 96; item += F.G) {
            const int l = item / 48, cgp = item % 48, col = cgp * 128 + F.lane * 2;
            const float* W = F.inp(4) + (size_t)l * 1024 * 6144 + col;
            float acc[5][2];
#pragma unroll
            for (int v = 0; v < 5; ++v) { acc[v][0] = 0.f; acc[v][1] = 0.f; }
            const int kbeg = F.wave * 128;
#pragma unroll 8
            for (int k = kbeg; k < kbeg + 128; ++k) {
                const f32x2 w = *(const f32x2*)(W + (size_t)k * 6144);
#pragma unroll
                for (int v = 0; v < 5; ++v) { const float s = S[v * 1024 + k]; acc[v][0] += s * w.x; acc[v][1] += s * w.y; }
            }
#pragma unroll
            for (int v = 0; v < 5; ++v) { red[(F.wave * 5 + v) * 128 + F.lane * 2] = acc[v][0]; red[(F.wave * 5 + v) * 128 + F.lane * 2 + 1] = acc[v][1]; }
            __syncthreads();
            for (int o = F.tid; o < 640; o += NTHR) { const int v = o >> 7, cc = o & 127; float s = F.inp(5)[l * 6144 + cgp * 128 + cc];
#pragma unroll
                for (int w = 0; w < 8; ++w) s += red[(w * 5 + v) * 128 + cc];
                ((float*)(ws + OFF_MODS))[(size_t)(l * 5 + v) * 6144 + cgp * 128 + cc] = s; }
            __syncthreads();
        }
        __syncthreads();
    }
    {
        LAS float* scr = (LAS float*)(F.lds + F.wave * 16384);
        const int gw = F.vcu * NWAVES + F.wave, NGW = F.G * NWAVES;
        const float* Wp[8]; int ldw[8], Kk[8], nb[8]; bf16_t* WT[8];
        Wp[0] = F.inp(14); ldw[0] = 2944; Kk[0] = 1024; nb[0] = 92; WT[0] = (bf16_t*)(ws + OFF_WIN0);
        Wp[1] = F.inp(15); ldw[1] = 1024; Kk[1] = 1024; nb[1] = 32; WT[1] = (bf16_t*)(ws + OFF_WOUT0);
        Wp[2] = F.inp(10); ldw[2] = 5632; Kk[2] = 1024; nb[2] = 176; WT[2] = (bf16_t*)(ws + OFF_WUP0);
        Wp[3] = F.inp(13); ldw[3] = 1024; Kk[3] = 2816; nb[3] = 32; WT[3] = (bf16_t*)(ws + OFF_WDN0);
        Wp[4] = F.inp(30); ldw[4] = 2064; Kk[4] = 1024; nb[4] = 64; WT[4] = (bf16_t*)(ws + OFF_WIN1);
        Wp[5] = F.inp(31); ldw[5] = 1024; Kk[5] = 1024; nb[5] = 32; WT[5] = (bf16_t*)(ws + OFF_WOUT1);
        Wp[6] = F.inp(10) + (size_t)1024 * 5632; ldw[6] = 5632; Kk[6] = 1024; nb[6] = 176; WT[6] = (bf16_t*)(ws + OFF_WUP1);
        Wp[7] = F.inp(13) + (size_t)2816 * 1024; ldw[7] = 1024; Kk[7] = 2816; nb[7] = 32; WT[7] = (bf16_t*)(ws + OFF_WDN1);
        int total = 0;
#pragma unroll
        for (int i = 0; i < 8; ++i) total += (Kk[i] / 64) * nb[i];
        for (int it = gw; it < total; it += NGW) {
            int r = it;
#pragma unroll
            for (int i = 0; i < 8; ++i) {
                const int cnt = (Kk[i] / 64) * nb[i];
                if (r >= 0 && r < cnt) { p0_transpose_item(Wp[i], ldw[i], Kk[i], WT[i], scr, r / nb[i], r % nb[i], F.lane); r = -1; }
                else if (r >= 0) r -= cnt;
            }
        }
    }
    {
        const int gt = blockIdx.x * NTHR + F.tid, GT = F.G * NTHR;
        bf16_t* w0 = (bf16_t*)(ws + OFF_WIN0); bf16_t* w1 = (bf16_t*)(ws + OFF_WIN1);
        for (int i = gt; i < 128 * 1024; i += GT) w0[(size_t)2944 * 1024 + i] = 0;
        for (int i = gt; i < 240 * 1024; i += GT) w1[(size_t)2064 * 1024 + i] = 0;
        for (int i = gt; i < 16 * 1024; i += GT) { const int n = i >> 10, k = i & 1023; w1[(size_t)(2048 + n) * 1024 + k] = f2bf(F.inp(30)[(size_t)k * 2064 + 2048 + n]); }
        bf16_t* wl = (bf16_t*)(ws + OFF_WL);
        for (int i = gt; i < 2560 * 384; i += GT) {
            const int k = i / 2560, n = i % 2560;
            const int a = n >> 9, c = n & 511; float v = 0.f;
            if (a < 2) { if ((k >> 6) == a) v = F.inp(21)[((size_t)a * 64 + (k & 63)) * 512 + c]; }
            else if (a < 4) { if ((k >> 6) == a) v = F.inp(23)[((size_t)(a - 2) * 64 + (k & 63)) * 512 + c]; }
            else { if (k >= 256) v = F.inp(24)[(size_t)(k - 256) * 512 + c]; }
            wl[(size_t)n * 384 + k] = f2bf(v);
        }
    }
}

struct RowArgs {
    const float* yf;
    const float* xin_lat; const float* xin_ctx; float* xout_lat; float* xout_ctx;
    const float* mods;
    int gate_idx; const float* g_post;
    bf16_t* H; const float* modsH; int shift_idx, scale_idx; const float* g_pre;
    int nrows;
};
__device__ __forceinline__ void phase_rows(Frame& F, const RowArgs& a) {
    const int gw = F.vcu * NWAVES + F.wave, NGW = F.G * NWAVES;
    for (int r = gw; r < a.nrows; r += NGW) {
        const int mv = row_mv(r);
        const float* xin = r < ML ? a.xin_lat + (size_t)r * DM : a.xin_ctx + (size_t)(r - ML) * DM;
        f32x4 x[4];
#pragma unroll
        for (int j = 0; j < 4; ++j) x[j] = *(const f32x4*)(xin + 4 * F.lane + 256 * j);
        if (a.yf) {
            f32x4 y[4]; float ss = 0.f;
#pragma unroll
            for (int j = 0; j < 4; ++j) { y[j] = *(const f32x4*)(a.yf + (size_t)r * DM + 4 * F.lane + 256 * j); ss += (y[j].x * y[j].x + y[j].y * y[j].y) + (y[j].z * y[j].z + y[j].w * y[j].w); }
            const float rinv = rsqrtf(wave_sum(ss) * (1.f / DM) + EPS);
            const float* gate = a.mods + (size_t)(mv * 6 + a.gate_idx) * DM;
            float* xout = r < ML ? a.xout_lat + (size_t)r * DM : a.xout_ctx + (size_t)(r - ML) * DM;
#pragma unroll
            for (int j = 0; j < 4; ++j) {
                const f32x4 gp = *(const f32x4*)(a.g_post + 4 * F.lane + 256 * j), gt = *(const f32x4*)(gate + 4 * F.lane + 256 * j);
                x[j] = x[j] + gt * (y[j] * rinv * gp);
                *(f32x4*)(xout + 4 * F.lane + 256 * j) = x[j];
            }
        }
        if (a.H) {
            float ss = 0.f;
#pragma unroll
            for (int j = 0; j < 4; ++j) ss += (x[j].x * x[j].x + x[j].y * x[j].y) + (x[j].z * x[j].z + x[j].w * x[j].w);
            const float rinv = rsqrtf(wave_sum(ss) * (1.f / DM) + EPS);
            const float* sh = a.modsH + (size_t)(mv * 6 + a.shift_idx) * DM; const float* sc = a.modsH + (size_t)(mv * 6 + a.scale_idx) * DM;
#pragma unroll
            for (int j = 0; j < 4; ++j) {
                const f32x4 gp = *(const f32x4*)(a.g_pre + 4 * F.lane + 256 * j), s1 = *(const f32x4*)(sc + 4 * F.lane + 256 * j), s0 = *(const f32x4*)(sh + 4 * F.lane + 256 * j);
                const f32x4 h = (x[j] * rinv * gp) * (1.0f + s1) + s0;
                u32x2 w; w.x = pkbf(h.x, h.y); w.y = pkbf(h.z, h.w);
                *(u32x2*)(a.H + (size_t)r * DM + 4 * F.lane + 256 * j) = w;
            }
        }
    }
}

__device__ __forceinline__ void phase_spatial_gate(Frame& F) {
    const bf16_t* GA = (const bf16_t*)(F.ws + OFF_RB);
    bf16_t* MIX = (bf16_t*)(F.ws + OFF_RA);
    LAS bf16_t* WsL = (LAS bf16_t*)F.lds;
    LAS bf16_t* VnT = (LAS bf16_t*)(F.lds + 34816);
    const float* a_ws = F.inp(16); const float* a_bs = F.inp(17); const float* a_gv = F.inp(18);
    const int fr = F.lane & 15, fq = F.lane >> 4;
    for (int item = F.vcu; item < (MR / 128) * 4; item += F.G) {
        const int ch = item >> 2, g = item & 3;
        {
            const int p = F.tid >> 2, q0 = (F.tid & 3) * 32;
            const float* src = a_ws + ((size_t)g * 128 + p) * 128 + q0;
#pragma unroll
            for (int i = 0; i < 4; ++i) { const f32x4 a = *(const f32x4*)(src + 8 * i), b = *(const f32x4*)(src + 8 * i + 4);
                u32x4 w; w.x = pkbf(a.x, a.y); w.y = pkbf(a.z, a.w); w.z = pkbf(b.x, b.y); w.w = pkbf(b.z, b.w);
                *(LAS u32x4*)(WsL + p * 136 + q0 + 8 * i) = w; }
        }
        {
            const int q = F.tid >> 2, c0 = (F.tid & 3) * 32;
            const bf16_t* src = GA + (size_t)(ch * 128 + q) * 1024 + 512 + g * 128 + c0;
            float v[32]; float ss = 0.f;
#pragma unroll
            for (int i = 0; i < 4; ++i) { unpack8(*(const u32x4*)(src + 8 * i), v + 8 * i); }
#pragma unroll
            for (int i = 0; i < 32; ++i) ss += v[i] * v[i];
            ss = red4(ss);
            const float rinv = rsqrtf(ss * (1.f / 128.f) + EPS);
#pragma unroll
            for (int i = 0; i < 32; ++i) VnT[(c0 + i) * 136 + q] = f2bf(v[i] * rinv * a_gv[g * 128 + c0 + i]);
        }
        __syncthreads();
        {
            const int w = F.wave;
            f32x4 acc[8];
#pragma unroll
            for (int nt = 0; nt < 8; ++nt) acc[nt] = (f32x4){0.f, 0.f, 0.f, 0.f};
#pragma unroll
            for (int ks = 0; ks < 4; ++ks) {
                const bf16x8 wf = *(const LAS bf16x8*)(WsL + (16 * w + fr) * 136 + 32 * ks + 8 * fq);
#pragma unroll
                for (int nt = 0; nt < 8; ++nt) {
                    const bf16x8 vf = *(const LAS bf16x8*)(VnT + (16 * nt + fr) * 136 + 32 * ks + 8 * fq);
                    acc[nt] = __builtin_amdgcn_mfma_f32_16x16x32_bf16(vf, wf, acc[nt], 0, 0, 0);
                }
            }
            const int p = 16 * w + fr; const float bs = a_bs[g * 128 + p];
            const size_t rowoff = (size_t)(ch * 128 + p) * 1024;
#pragma unroll
            for (int nt = 0; nt < 8; ++nt) {
                const int c = g * 128 + 16 * nt + 4 * fq;
                const u32x2 uu = *(const u32x2*)(GA + rowoff + c);
                const float o0 = bf_lo(uu.x) * (acc[nt][0] + bs), o1 = bf_hi(uu.x) * (acc[nt][1] + bs), o2 = bf_lo(uu.y) * (acc[nt][2] + bs), o3 = bf_hi(uu.y) * (acc[nt][3] + bs);
                u32x2 o; o.x = pkbf(o0, o1); o.y = pkbf(o2, o3);
                *(u32x2*)(MIX + rowoff + c) = o;
            }
        }
        __syncthreads();
    }
}

__device__ __forceinline__ int rwkv_row(int b, int d, int gs) {
    if (gs < TC) { const int t = d ? (TC - 1 - gs) : gs; return ML + b * TC + t; }
    const int q = gs - TC; const int t = d ? (TL - 1 - q) : q; return b * TL + t;
}
__device__ __forceinline__ void phase_rwkv_scan(Frame& F) {
    constexpr int TS = 32, NT = (TC + TL) / TS, BUF = 43008;
    const bf16_t* P = (const bf16_t*)(F.ws + OFF_RC);
    const bf16_t* LO = (const bf16_t*)(F.ws + OFF_RE);
    bf16_t* Y = (bf16_t*)(F.ws + OFF_RB);
    const float* b_shift = F.inp(19); const float* b_kk = F.inp(25); const float* b_ka = F.inp(26);
    LAS float* CW = (LAS float*)(F.lds + 2 * BUF);
    for (int item = F.vcu; item < 256; item += F.G) {
        const int seq = item >> 2, rg = item & 3, b = seq >> 4, h = (seq >> 1) & 7, d = seq & 1;
        __syncthreads();
        for (int i = F.tid; i < 576 + 128; i += NTHR) {
            if (i < 576) { const int tap = i / 192, arr = (i / 64) % 3, c = i & 63; CW[i] = b_shift[tap * 1536 + arr * 512 + h * 64 + c]; }
            else if (i < 640) CW[i] = b_kk[h * 64 + (i - 576)];
            else CW[i] = b_ka[h * 64 + (i - 640)];
        }
        __syncthreads();
        float st0 = 0.f, st1 = 0.f, st2 = 0.f, st3 = 0.f;
        const bool loader = F.tid >= 256;
        const int lt = F.tid - 256, ls = lt >> 3, lcg = lt & 7;
        const int rr = F.tid >> 4, ks = F.tid & 15;
        for (int tile = -1; tile < NT; ++tile) {
            if (loader) {
                const int tl = tile + 1;
                if (tl < NT) {
                    LAS float* buf = (LAS float*)(F.lds + (tl & 1) * BUF);
                    const int gs = tl * TS + ls; const int row = rwkv_row(b, d, gs);
                    bool hp, hn; row_nbr(row, hp, hn);
                    float val[3][8];
#pragma unroll
                    for (int arr = 0; arr < 3; ++arr) {
                        const bf16_t* src = P + (size_t)row * 1536 + arr * 512 + h * 64 + lcg * 8;
                        float xc[8], xp[8], xn[8];
                        unpack8(*(const u32x4*)src, xc);
                        if (hp) unpack8(*(const u32x4*)(src - 1536), xp); else {
#pragma unroll
                            for (int j = 0; j < 8; ++j) xp[j] = 0.f; }
                        if (hn) unpack8(*(const u32x4*)(src + 1536), xn); else {
#pragma unroll
                            for (int j = 0; j < 8; ++j) xn[j] = 0.f; }
#pragma unroll
                        for (int j = 0; j < 8; ++j) { const int c = lcg * 8 + j; val[arr][j] = xp[j] * CW[(0 * 3 + arr) * 64 + c] + xc[j] * CW[(1 * 3 + arr) * 64 + c] + xn[j] * CW[(2 * 3 + arr) * 64 + c]; }
                    }
                    float av[8], lw[8];
                    unpack8(*(const u32x4*)(LO + ((size_t)(2 + d) * MR + row) * 512 + h * 64 + lcg * 8), av);
                    unpack8(*(const u32x4*)(LO + ((size_t)d * MR + row) * 512 + h * 64 + lcg * 8), lw);
                    float kkr[8]; float ss = 0.f;
#pragma unroll
                    for (int j = 0; j < 8; ++j) { kkr[j] = val[1][j] * CW[576 + lcg * 8 + j]; ss += kkr[j] * kkr[j]; }
                    ss = red8(ss);
                    const float inv = rsqrtf(fmaxf(ss, 1e-12f));
                    float ow[8], okd[8], okk[8], obb[8];
#pragma unroll
                    for (int j = 0; j < 8; ++j) {
                        const float kk = kkr[j] * inv;
                        okk[j] = kk; obb[j] = kk * av[j];
                        okd[j] = val[1][j] * (1.0f + (av[j] - 1.0f) * CW[640 + lcg * 8 + j]);
                        ow[j] = __expf(lw[j]);
                    }
                    const int o = ls * 64 + lcg * 8;
                    *(LAS f32x4*)(buf + 0 * 2048 + o) = (f32x4){ow[0], ow[1], ow[2], ow[3]};   *(LAS f32x4*)(buf + 0 * 2048 + o + 4) = (f32x4){ow[4], ow[5], ow[6], ow[7]};
                    *(LAS f32x4*)(buf + 1 * 2048 + o) = (f32x4){okd[0], okd[1], okd[2], okd[3]}; *(LAS f32x4*)(buf + 1 * 2048 + o + 4) = (f32x4){okd[4], okd[5], okd[6], okd[7]};
                    *(LAS f32x4*)(buf + 2 * 2048 + o) = (f32x4){okk[0], okk[1], okk[2], okk[3]}; *(LAS f32x4*)(buf + 2 * 2048 + o + 4) = (f32x4){okk[4], okk[5], okk[6], okk[7]};
                    *(LAS f32x4*)(buf + 3 * 2048 + o) = (f32x4){obb[0], obb[1], obb[2], obb[3]}; *(LAS f32x4*)(buf + 3 * 2048 + o + 4) = (f32x4){obb[4], obb[5], obb[6], obb[7]};
                    *(LAS f32x4*)(buf + 4 * 2048 + o) = (f32x4){val[0][0], val[0][1], val[0][2], val[0][3]}; *(LAS f32x4*)(buf + 4 * 2048 + o + 4) = (f32x4){val[0][4], val[0][5], val[0][6], val[0][7]};
                    if ((lcg >> 1) == rg) {
                        const int vo = 5 * 2048 + ls * 16 + (lcg & 1) * 8;
                        *(LAS f32x4*)(buf + vo) = (f32x4){val[2][0], val[2][1], val[2][2], val[2][3]}; *(LAS f32x4*)(buf + vo + 4) = (f32x4){val[2][4], val[2][5], val[2][6], val[2][7]};
                    }
                }
            } else if (tile >= 0) {
                const LAS float* buf = (const LAS float*)(F.lds + (tile & 1) * BUF);
                bf16_t* yo = Y + (size_t)d * MR * 512 + h * 64 + rg * 16 + rr;
#pragma unroll 4
                for (int s = 0; s < TS; ++s) {
                    const f32x4 w4 = *(const LAS f32x4*)(buf + 0 * 2048 + s * 64 + ks * 4);
                    const f32x4 kd4 = *(const LAS f32x4*)(buf + 1 * 2048 + s * 64 + ks * 4);
                    const f32x4 kk4 = *(const LAS f32x4*)(buf + 2 * 2048 + s * 64 + ks * 4);
                    const f32x4 bb4 = *(const LAS f32x4*)(buf + 3 * 2048 + s * 64 + ks * 4);
                    const f32x4 r4 = *(const LAS f32x4*)(buf + 4 * 2048 + s * 64 + ks * 4);
                    const float v = buf[5 * 2048 + s * 16 + rr];
                    float sa = (st0 * kk4.x + st1 * kk4.y) + (st2 * kk4.z + st3 * kk4.w);
                    sa = red16(sa);
                    st0 = st0 * w4.x - sa * bb4.x + v * kd4.x;
                    st1 = st1 * w4.y - sa * bb4.y + v * kd4.y;
                    st2 = st2 * w4.z - sa * bb4.z + v * kd4.z;
                    st3 = st3 * w4.w - sa * bb4.w + v * kd4.w;
                    float y = (st0 * r4.x + st1 * r4.y) + (st2 * r4.z + st3 * r4.w);
                    y = red16(y);
                    if (ks == 0) yo[(size_t)rwkv_row(b, d, tile * TS + s) * 512] = f2bf(y);
                }
            }
            __syncthreads();
        }
    }
}

__device__ __forceinline__ void phase_rwkv_out(Frame& F) {
    const bf16_t* P = (const bf16_t*)(F.ws + OFF_RC);
    const bf16_t* LO = (const bf16_t*)(F.ws + OFF_RE);
    const bf16_t* Y = (const bf16_t*)(F.ws + OFF_RB);
    bf16_t* MIX = (bf16_t*)(F.ws + OFF_RA);
    const float* b_shift = F.inp(19); const float* b_ka = F.inp(26); const float* b_rk = F.inp(27); const float* ln_g = F.inp(28); const float* ln_b = F.inp(29);
    const int gw = F.vcu * NWAVES + F.wave, NGW = F.G * NWAVES, c0 = F.lane * 8;
    for (int r = gw; r < MR; r += NGW) {
        bool hp, hn; row_nbr(r, hp, hn);
        float val[3][8];
#pragma unroll
        for (int arr = 0; arr < 3; ++arr) {
            const bf16_t* src = P + (size_t)r * 1536 + arr * 512 + c0;
            float xc[8], xp[8], xn[8];
            unpack8(*(const u32x4*)src, xc);
            if (hp) unpack8(*(const u32x4*)(src - 1536), xp); else {
#pragma unroll
                for (int j = 0; j < 8; ++j) xp[j] = 0.f; }
            if (hn) unpack8(*(const u32x4*)(src + 1536), xn); else {
#pragma unroll
                for (int j = 0; j < 8; ++j) xn[j] = 0.f; }
#pragma unroll
            for (int j = 0; j < 8; ++j) { const int c = arr * 512 + c0 + j; val[arr][j] = xp[j] * b_shift[c] + xc[j] * b_shift[1536 + c] + xn[j] * b_shift[3072 + c]; }
        }
        float y0[8], y1[8], a0[8], a1[8], g[8];
        unpack8(*(const u32x4*)(Y + (size_t)r * 512 + c0), y0);
        unpack8(*(const u32x4*)(Y + ((size_t)MR + r) * 512 + c0), y1);
        unpack8(*(const u32x4*)(LO + ((size_t)2 * MR + r) * 512 + c0), a0);
        unpack8(*(const u32x4*)(LO + ((size_t)3 * MR + r) * 512 + c0), a1);
        unpack8(*(const u32x4*)(LO + ((size_t)4 * MR + r) * 512 + c0), g);
        float s1 = 0.f, ts = 0.f;
#pragma unroll
        for (int j = 0; j < 8; ++j) { y0[j] += y1[j]; s1 += y0[j];
            const float ka = b_ka[c0 + j];
            ts += val[0][j] * val[1][j] * b_rk[c0 + j] * (2.0f + (a0[j] + a1[j] - 2.0f) * ka); }
        s1 = red8(s1); ts = red8(ts);
        const float mu = s1 * (1.f / 64.f); float s2 = 0.f;
#pragma unroll
        for (int j = 0; j < 8; ++j) { y0[j] -= mu; s2 += y0[j] * y0[j]; }
        s2 = red8(s2);
        const float rstd = rsqrtf(s2 * (1.f / 64.f) + LN_EPS);
        float o[8];
#pragma unroll
        for (int j = 0; j < 8; ++j) { const float yn = y0[j] * rstd * ln_g[c0 + j] + ln_b[c0 + j]; o[j] = (yn + ts * val[2][j]) * g[j]; }
        *(u32x4*)(MIX + (size_t)r * 1024 + 512 + c0) = pack8(o);
    }
}

__device__ __forceinline__ void phase_conv(Frame& F, const bf16_t* UA, bf16_t* UB, const float* cw, const float* cb, int nrows) {
    const int gt = F.vcu * NTHR + F.tid, GT = F.G * NTHR;
    const int total = nrows * 352;
    for (int idx = gt; idx < total; idx += GT) {
        const int row = idx / 352, c0 = (idx % 352) * 8;
        float acc[8];
        { const f32x4 a = *(const f32x4*)(cb + c0), b = *(const f32x4*)(cb + c0 + 4); acc[0] = a.x; acc[1] = a.y; acc[2] = a.z; acc[3] = a.w; acc[4] = b.x; acc[5] = b.y; acc[6] = b.z; acc[7] = b.w; }
        if (row < ML) {
            const int bb = row >> 13, t = row & (TL - 1), gi = t >> 6, gj = t & 63;
#pragma unroll
            for (int di = -1; di <= 1; ++di) {
                const int ii = gi + di; if (ii < 0 || ii > 127) continue;
#pragma unroll
                for (int dj = -1; dj <= 1; ++dj) {
                    const int jj = gj + dj; if (jj < 0 || jj > 63) continue;
                    const int nrow = (bb << 13) + ii * 64 + jj;
                    float x[8]; unpack8(*(const u32x4*)(UA + (size_t)nrow * DFF + c0), x);
                    const float* w = cw + ((di + 1) * 3 + (dj + 1)) * DFF + c0;
                    const f32x4 wa = *(const f32x4*)w, wb = *(const f32x4*)(w + 4);
                    acc[0] += x[0] * wa.x; acc[1] += x[1] * wa.y; acc[2] += x[2] * wa.z; acc[3] += x[3] * wa.w;
                    acc[4] += x[4] * wb.x; acc[5] += x[5] * wb.y; acc[6] += x[6] * wb.z; acc[7] += x[7] * wb.w;
                }
            }
        } else {
            const int t = (row - ML) & (TC - 1);
#pragma unroll
            for (int dj = -1; dj <= 1; ++dj) {
                const int tt = t + dj; if (tt < 0 || tt > TC - 1) continue;
                float x[8]; unpack8(*(const u32x4*)(UA + (size_t)(row + dj) * DFF + c0), x);
                const float* w = cw + (3 + (dj + 1)) * DFF + c0;
                const f32x4 wa = *(const f32x4*)w, wb = *(const f32x4*)(w + 4);
                acc[0] += x[0] * wa.x; acc[1] += x[1] * wa.y; acc[2] += x[2] * wa.z; acc[3] += x[3] * wa.w;
                acc[4] += x[4] * wb.x; acc[5] += x[5] * wb.y; acc[6] += x[6] * wb.z; acc[7] += x[7] * wb.w;
            }
        }
        float bv[8]; unpack8(*(const u32x4*)(UB + (size_t)row * DFF + c0), bv);
#pragma unroll
        for (int j = 0; j < 8; ++j) acc[j] = gelu_tanh(acc[j]) * bv[j];
        *(u32x4*)(UB + (size_t)row * DFF + c0) = pack8(acc);
    }
}

__device__ __forceinline__ void phase_mlstm_prep(Frame& F) {
    const bf16_t* XM = (const bf16_t*)(F.ws + OFF_XM);
    bf16_t* Q = (bf16_t*)(F.ws + OFF_Q); bf16_t* K = (bf16_t*)(F.ws + OFF_K);
    const float* c_conv = F.inp(32); const float* c_conv_b = F.inp(33); const float* wq = F.inp(34); const float* wk = F.inp(35);
    {
        const int gt = F.vcu * NTHR + F.tid, GT = F.G * NTHR;
        for (int idx = gt; idx < MR * 128; idx += GT) {
            const int row = idx >> 7, c0 = (idx & 127) * 8;
            bool hp, hn; row_nbr(row, hp, hn);
            const bf16_t* src = XM + (size_t)row * 1024 + c0;
            float xc[8], xp[8], xn[8], xcv[8];
            unpack8(*(const u32x4*)src, xc);
            if (hp) unpack8(*(const u32x4*)(src - 1024), xp); else {
#pragma unroll
                for (int j = 0; j < 8; ++j) xp[j] = 0.f; }
            if (hn) unpack8(*(const u32x4*)(src + 1024), xn); else {
#pragma unroll
                for (int j = 0; j < 8; ++j) xn[j] = 0.f; }
#pragma unroll
            for (int j = 0; j < 8; ++j) xcv[j] = siluf_(xp[j] * c_conv[c0 + j] + xc[j] * c_conv[1024 + c0 + j] + xn[j] * c_conv[2048 + c0 + j] + c_conv_b[c0 + j]);
            float q[8], k[8];
#pragma unroll
            for (int g = 0; g < 2; ++g) {
                const float* wqg = wq + (size_t)(c0 / 4 + g) * 16; const float* wkg = wk + (size_t)(c0 / 4 + g) * 16;
#pragma unroll
                for (int o = 0; o < 4; ++o) {
                    float sq = 0.f, sk = 0.f;
#pragma unroll
                    for (int i = 0; i < 4; ++i) { sq += xcv[g * 4 + i] * wqg[i * 4 + o]; sk += xcv[g * 4 + i] * wkg[i * 4 + o]; }
                    q[g * 4 + o] = sq; k[g * 4 + o] = sk * 0.0625f;
                }
            }
            *(u32x4*)(Q + (size_t)row * 1024 + c0) = pack8(q);
            *(u32x4*)(K + (size_t)row * 1024 + c0) = pack8(k);
        }
    }
    {
        const float* GATES = (const float*)(F.ws + OFF_GATES);
        float* E = (float*)(F.ws + OFF_E); float* Bc = (float*)(F.ws + OFF_E + EB_STRIDE); float* GC = (float*)(F.ws + OFF_E + 2 * EB_STRIDE);
        float* CHS = (float*)(F.ws + OFF_CHS);
        const float* c_bi = F.inp(37); const float* c_bf = F.inp(38);
        const int gw = F.vcu * NWAVES + F.wave, NGW = F.G * NWAVES;
        for (int it = gw; it < 32 * 66; it += NGW) {
            const int sq = it / 66, n = it % 66, b = sq >> 3, h = (sq >> 1) & 3, d = sq & 1;
            int rb;
            if (n < 2) { const int oc = d ? 1 - n : n; rb = ML + b * TC + oc * 128; }
            else { const int oc = d ? 63 - (n - 2) : n - 2; rb = b * TL + oc * 128; }
            const int j0 = 2 * F.lane, j1 = j0 + 1, p0 = d ? 127 - j0 : j0, p1 = d ? 127 - j1 : j1;
            const float bi = c_bi[d * 4 + h], bfv = c_bf[d * 4 + h];
            const float li0 = GATES[(size_t)(rb + p0) * 16 + d * 4 + h] + bi, li1 = GATES[(size_t)(rb + p1) * 16 + d * 4 + h] + bi;
            const float lf0 = logsigmoidf_(GATES[(size_t)(rb + p0) * 16 + 8 + d * 4 + h] + bfv), lf1 = logsigmoidf_(GATES[(size_t)(rb + p1) * 16 + 8 + d * 4 + h] + bfv);
            float incl = lf0 + lf1;
#pragma unroll
            for (int o = 1; o < 64; o <<= 1) { const float t = __shfl_up(incl, o); if (F.lane >= o) incl += t; }
            const float b1 = incl, b0 = incl - lf1;
            const float e0 = li0 - b0, e1 = li1 - b1;
            float cm = fmaxf(e0, e1);
#pragma unroll
            for (int o = 1; o < 64; o <<= 1) { const float t = __shfl_up(cm, o); if (F.lane >= o) cm = fmaxf(cm, t); }
            float cmp = __shfl_up(cm, 1); if (F.lane == 0) cmp = -INFINITY;
            const float gc0 = fmaxf(cmp, e0), gc1 = cm;
            const size_t base = ((size_t)sq * 66 + n) * 128;
            E[base + p0] = e0; E[base + p1] = e1; Bc[base + p0] = b0; Bc[base + p1] = b1; GC[base + p0] = gc0; GC[base + p1] = gc1;
            if (F.lane == 63) { CHS[(sq * 66 + n) * 2] = b1; CHS[(sq * 66 + n) * 2 + 1] = cm; }
        }
    }
}

__device__ __forceinline__ void mlstm_chain(Frame& F, int sq, LAS float* MCH, LAS float* CHL) {
    const float* CHS = (const float*)(F.ws + OFF_CHS);
    __syncthreads();
    for (int i = F.tid; i < 132; i += NTHR) CHL[i] = CHS[sq * 132 + i];
    __syncthreads();
    if (F.tid == 0) { float m = 0.f; MCH[0] = 0.f; for (int n = 0; n < 66; ++n) { m = CHL[2 * n] + fmaxf(m, CHL[2 * n + 1]); MCH[n + 1] = m; } }
    __syncthreads();
}

__device__ __forceinline__ void phase_mlstm_s(Frame& F) {
    const bf16_t* Q = (const bf16_t*)(F.ws + OFF_Q); const bf16_t* K = (const bf16_t*)(F.ws + OFF_K);
    bf16_t* S = (bf16_t*)(F.ws + OFF_S);
    const float* E = (const float*)(F.ws + OFF_E); const float* GC = (const float*)(F.ws + OFF_E + 2 * EB_STRIDE);
    LAS float* MCH = (LAS float*)F.lds; LAS float* CHL = MCH + 128; LAS float* EL = MCH + 384; LAS float* GL = MCH + 512;
    const int fr = F.lane & 15, fq = F.lane >> 4, w = F.wave;
    for (int blk = F.vcu; blk < 256; blk += F.G) {
        const int sq = blk >> 3, cgrp = blk & 7, b = sq >> 3, h = (sq >> 1) & 3, d = sq & 1;
        mlstm_chain(F, sq, MCH, CHL);
        for (int i = 0; i < 8; ++i) {
            const int n = 2 + 8 * cgrp + i, oc = d ? 63 - (n - 2) : n - 2, rb = b * TL + oc * 128;
            const float m = MCH[n];
            __syncthreads();
            if (F.tid < 128) { EL[F.tid] = E[((size_t)sq * 66 + n) * 128 + F.tid]; GL[F.tid] = GC[((size_t)sq * 66 + n) * 128 + F.tid]; }
            __syncthreads();
            bf16x8 qf[8];
#pragma unroll
            for (int ks = 0; ks < 8; ++ks) qf[ks] = *(const bf16x8*)(Q + (size_t)(rb + 16 * w + fr) * 1024 + h * 256 + 32 * ks + 8 * fq);
            const int p = 16 * w + fr; const float Mp = fmaxf(m, GL[p]);
            bf16_t* so = S + (((size_t)sq * 64 + oc) * 128 + p) * 128;
#pragma unroll 2
            for (int nt = 0; nt < 8; ++nt) {
                f32x4 acc = (f32x4){0.f, 0.f, 0.f, 0.f};
#pragma unroll
                for (int ks = 0; ks < 8; ++ks) {
                    const bf16x8 kf = *(const bf16x8*)(K + (size_t)(rb + 16 * nt + fr) * 1024 + h * 256 + 32 * ks + 8 * fq);
                    acc = __builtin_amdgcn_mfma_f32_16x16x32_bf16(kf, qf[ks], acc, 0, 0, 0);
                }
                float o[4];
#pragma unroll
                for (int r = 0; r < 4; ++r) { const int u = 16 * nt + 4 * fq + r; const bool ok = d ? (u >= p) : (u <= p); o[r] = ok ? acc[r] * __expf(EL[u] - Mp) : 0.f; }
                u32x2 ov; ov.x = pkbf(o[0], o[1]); ov.y = pkbf(o[2], o[3]);
                *(u32x2*)(so + 16 * nt + 4 * fq) = ov;
            }
        }
    }
}

__device__ __forceinline__ void phase_mlstm_scan(Frame& F) {
    const bf16_t* Q = (const bf16_t*)(F.ws + OFF_Q); const bf16_t* K = (const bf16_t*)(F.ws + OFF_K); const bf16_t* XM = (const bf16_t*)(F.ws + OFF_XM);
    const bf16_t* S = (const bf16_t*)(F.ws + OFF_S);
    const float* E = (const float*)(F.ws + OFF_E); const float* Bc = (const float*)(F.ws + OFF_E + EB_STRIDE); const float* GC = (const float*)(F.ws + OFF_E + 2 * EB_STRIDE);
    const float* c_wv = F.inp(36);
    LAS bf16_t* KL = (LAS bf16_t*)F.lds;
    LAS bf16_t* Cs = (LAS bf16_t*)(F.lds + 67584);
    LAS bf16_t* VT = (LAS bf16_t*)(F.lds + 92928);
    LAS bf16_t* VsT = (LAS bf16_t*)(F.lds + 105984);
    LAS float* WI = (LAS float*)(F.lds + 119040); LAS float* FL = WI + 128; LAS float* SC = WI + 256;
    LAS float* MCH = WI + 384; LAS float* CHL = WI + 512;
    const int fr = F.lane & 15, fq = F.lane >> 4, w = F.wave;
    for (int item = F.vcu; item < 256; item += F.G) {
        const int sq = item >> 3, sl = item & 7, b = sq >> 3, h = (sq >> 1) & 3, d = sq & 1;
        bf16_t* HO = (bf16_t*)(F.ws + (d ? OFF_HO1 : OFF_HO0));
        mlstm_chain(F, sq, MCH, CHL);
        for (int i = F.tid; i < 48 * 264; i += NTHR) Cs[i] = 0;
        for (int i = F.tid; i < 48 * 136; i += NTHR) { VT[i] = 0; VsT[i] = 0; }
        f32x4 Cacc[3][2];
#pragma unroll
        for (int mt = 0; mt < 3; ++mt)
#pragma unroll
            for (int nt = 0; nt < 2; ++nt) Cacc[mt][nt] = (f32x4){0.f, 0.f, 0.f, 0.f};
        __syncthreads();
        for (int n = 0; n < 66; ++n) {
            const bool is_ctx = n < 2;
            int rb, oc;
            if (is_ctx) { oc = d ? 1 - n : n; rb = ML + b * TC + oc * 128; } else { oc = d ? 63 - (n - 2) : n - 2; rb = b * TL + oc * 128; }
            const float m = MCH[n], Mlast = fmaxf(m, CHL[2 * n + 1]), carry = __expf(m - Mlast);
            if (F.tid < 128) {
                const size_t base = ((size_t)sq * 66 + n) * 128 + F.tid;
                const float e = E[base], bb = Bc[base], gc = GC[base], Mp = fmaxf(m, gc);
                WI[F.tid] = __expf(m - Mp); FL[F.tid] = __expf(-bb - Mp); SC[F.tid] = __expf(e - Mlast);
            }
            __syncthreads();
#pragma unroll
            for (int i = 0; i < 2; ++i) {
                const int idx = F.tid + NTHR * i, s = idx >> 3, g = idx & 7, cb = h * 256 + sl * 32 + g * 4;
                const u32x2 xw = *(const u32x2*)(XM + (size_t)(rb + s) * 1024 + cb);
                const float x0 = bf_lo(xw.x), x1 = bf_hi(xw.x), x2 = bf_lo(xw.y), x3 = bf_hi(xw.y);
                const float* wv = c_wv + (size_t)(cb / 4) * 16; const float sc = SC[s];
#pragma unroll
                for (int o = 0; o < 4; ++o) { const float v = x0 * wv[o] + x1 * wv[4 + o] + x2 * wv[8 + o] + x3 * wv[12 + o];
                    VT[(g * 4 + o) * 136 + s] = f2bf(v); VsT[(g * 4 + o) * 136 + s] = f2bf(v * sc); }
                if (g == 0) { VT[32 * 136 + s] = 0x3F80; VsT[32 * 136 + s] = f2bf(sc); }
            }
#pragma unroll
            for (int i = 0; i < 8; ++i) {
                const int idx = F.tid + NTHR * i, s = idx >> 5, c16 = idx & 31;
                *(LAS u32x4*)(KL + s * 264 + c16 * 8) = *(const u32x4*)(K + (size_t)(rb + s) * 1024 + h * 256 + c16 * 8);
            }
            __syncthreads();
            if (!is_ctx) {
                f32x4 a2[3], a3[3];
#pragma unroll
                for (int nt = 0; nt < 3; ++nt) { a2[nt] = (f32x4){0.f, 0.f, 0.f, 0.f}; a3[nt] = (f32x4){0.f, 0.f, 0.f, 0.f}; }
                const bf16_t* sp = S + (((size_t)sq * 64 + oc) * 128 + 16 * w + fr) * 128 + 8 * fq;
#pragma unroll
                for (int ks = 0; ks < 4; ++ks) {
                    const bf16x8 sf = *(const bf16x8*)(sp + 32 * ks);
#pragma unroll
                    for (int nt = 0; nt < 3; ++nt) { const bf16x8 vf = *(const LAS bf16x8*)(VT + (16 * nt + fr) * 136 + 32 * ks + 8 * fq); a2[nt] = __builtin_amdgcn_mfma_f32_16x16x32_bf16(vf, sf, a2[nt], 0, 0, 0); }
                }
                const bf16_t* qp = Q + (size_t)(rb + 16 * w + fr) * 1024 + h * 256 + 8 * fq;
#pragma unroll
                for (int ks = 0; ks < 8; ++ks) {
                    const bf16x8 qf = *(const bf16x8*)(qp + 32 * ks);
#pragma unroll
                    for (int nt = 0; nt < 3; ++nt) { const bf16x8 cf = *(const LAS bf16x8*)(Cs + (16 * nt + fr) * 264 + 32 * ks + 8 * fq); a3[nt] = __builtin_amdgcn_mfma_f32_16x16x32_bf16(cf, qf, a3[nt], 0, 0, 0); }
                }
                const float wi = WI[16 * w + fr], fl = FL[16 * w + fr];
                const float den0 = a2[2][0] + wi * a3[2][0];
                const float den = __shfl(den0, fr);
                const float inv = 1.0f / fmaxf(fabsf(den), fl);
                bf16_t* ho = HO + (size_t)(rb + 16 * w + fr) * 1024 + h * 256 + sl * 32 + 4 * fq;
#pragma unroll
                for (int nt = 0; nt < 2; ++nt) {
                    float o[4];
#pragma unroll
                    for (int r = 0; r < 4; ++r) o[r] = (a2[nt][r] + wi * a3[nt][r]) * inv;
                    u32x2 ov; ov.x = pkbf(o[0], o[1]); ov.y = pkbf(o[2], o[3]);
                    *(u32x2*)(ho + 16 * nt) = ov;
                }
            }
#pragma unroll
            for (int mt = 0; mt < 3; ++mt)
#pragma unroll
                for (int nt = 0; nt < 2; ++nt) Cacc[mt][nt] = Cacc[mt][nt] * carry;
#pragma unroll
            for (int ks = 0; ks < 4; ++ks) {
                bf16x8 kf[2];
#pragma unroll
                for (int nt = 0; nt < 2; ++nt)
#pragma unroll
                    for (int e = 0; e < 8; ++e) kf[nt][e] = (short)KL[(32 * ks + 8 * fq + e) * 264 + 32 * w + 16 * nt + fr];
#pragma unroll
                for (int mt = 0; mt < 3; ++mt) {
                    const bf16x8 vf = *(const LAS bf16x8*)(VsT + (16 * mt + fr) * 136 + 32 * ks + 8 * fq);
#pragma unroll
                    for (int nt = 0; nt < 2; ++nt) Cacc[mt][nt] = __builtin_amdgcn_mfma_f32_16x16x32_bf16(vf, kf[nt], Cacc[mt][nt], 0, 0, 0);
                }
            }
            __syncthreads();
#pragma unroll
            for (int mt = 0; mt < 3; ++mt)
#pragma unroll
                for (int nt = 0; nt < 2; ++nt)
#pragma unroll
                    for (int r = 0; r < 4; ++r) Cs[(16 * mt + 4 * fq + r) * 264 + 32 * w + 16 * nt + fr] = f2bf(Cacc[mt][nt][r]);
        }
        __syncthreads();
    }
}

__device__ __forceinline__ void phase_mlstm_out(Frame& F) {
    const bf16_t* H0 = (const bf16_t*)(F.ws + OFF_HO0); const bf16_t* H1 = (const bf16_t*)(F.ws + OFF_HO1);
    const bf16_t* XM = (const bf16_t*)(F.ws + OFF_XM); const bf16_t* SZ = (const bf16_t*)(F.ws + OFF_SZ);
    bf16_t* MIX = (bf16_t*)(F.ws + OFF_MIX1);
    const float* c_conv = F.inp(32); const float* c_conv_b = F.inp(33); const float* c_norm = F.inp(39); const float* c_skip = F.inp(40);
    const int gw = F.vcu * NWAVES + F.wave, NGW = F.G * NWAVES, c0 = F.lane * 16;
    for (int r = gw; r < ML; r += NGW) {
        bool hp, hn; row_nbr(r, hp, hn);
        float hsum[16]; float ss = 0.f;
#pragma unroll
        for (int half = 0; half < 2; ++half) {
            float a[8], b[8];
            unpack8(*(const u32x4*)(H0 + (size_t)r * 1024 + c0 + 8 * half), a);
            unpack8(*(const u32x4*)(H1 + (size_t)r * 1024 + c0 + 8 * half), b);
#pragma unroll
            for (int j = 0; j < 8; ++j) { hsum[8 * half + j] = a[j] + b[j]; ss += hsum[8 * half + j] * hsum[8 * half + j]; }
        }
        ss = red16(ss);
        const float rinv = rsqrtf(ss * (1.f / 256.f) + EPS);
#pragma unroll
        for (int half = 0; half < 2; ++half) {
            const int cc = c0 + 8 * half;
            const bf16_t* src = XM + (size_t)r * 1024 + cc;
            float xc[8], xp[8], xn[8], sz[8], o[8];
            unpack8(*(const u32x4*)src, xc);
            if (hp) unpack8(*(const u32x4*)(src - 1024), xp); else {
#pragma unroll
                for (int j = 0; j < 8; ++j) xp[j] = 0.f; }
            if (hn) unpack8(*(const u32x4*)(src + 1024), xn); else {
#pragma unroll
                for (int j = 0; j < 8; ++j) xn[j] = 0.f; }
            unpack8(*(const u32x4*)(SZ + (size_t)r * 1024 + cc), sz);
#pragma unroll
            for (int j = 0; j < 8; ++j) {
                const float xcv = siluf_(xp[j] * c_conv[cc + j] + xc[j] * c_conv[1024 + cc + j] + xn[j] * c_conv[2048 + cc + j] + c_conv_b[cc + j]);
                const float hnv = hsum[8 * half + j] * rinv * c_norm[cc + j];
                o[j] = (hnv + c_skip[cc + j] * xcv) * sz[j];
            }
            *(u32x4*)(MIX + (size_t)r * 1024 + cc) = pack8(o);
        }
    }
}

constexpr int N_PHASES = 23;
struct Args { const float* in[41]; float* out; unsigned char* ws; int ph_lo, ph_hi; };

__global__ void __launch_bounds__(NTHR, 2) mk_fwd(Args a) {
    extern __shared__ __attribute__((aligned(16))) unsigned char lds_raw[];
    Frame F;
    F.lds = (LAS unsigned char*)lds_raw;
    F.tid = threadIdx.x; F.lane = F.tid & 63; F.wave = __builtin_amdgcn_readfirstlane(F.tid >> 6);
    F.G = gridDim.x; { const int bx = blockIdx.x; F.vcu = (F.G % 8 == 0) ? (bx % 8) * (F.G / 8) + bx / 8 : bx; }
    F.out = a.out; F.ws = a.ws;
    if (F.tid == 0) {
        LAS unsigned long long* t = (LAS unsigned long long*)(F.lds + PTR_TBL_OFF);
#pragma unroll
        for (int i = 0; i < 41; ++i) t[i] = (unsigned long long)a.in[i];
    }
    __syncthreads();
    unsigned char* ws = a.ws;
    float* mods0 = (float*)(ws + OFF_MODS); float* mods1 = mods0 + 5 * 6144;
    float* XC = (float*)(ws + OFF_XC);
    cg::grid_group grid = cg::this_grid();

#ifndef P3_PART
#define P3_PART 3
#endif
#ifndef PH_MASK
#define PH_MASK 0xFFFFFFFFu
#endif
    const int lo = a.ph_lo, hi = a.ph_hi;
#define LAUNDER() do { unsigned long long w_ = (unsigned long long)a.ws; asm volatile("" : "+s"(w_)); ws = (unsigned char*)w_; F.ws = ws; \
          unsigned long long o_ = (unsigned long long)a.out; asm volatile("" : "+s"(o_)); F.out = (float*)o_; \
          int t_ = threadIdx.x; asm volatile("" : "+v"(t_)); F.tid = t_; F.lane = t_ & 63; F.wave = __builtin_amdgcn_readfirstlane(t_ >> 6); \
          mods0 = (float*)(ws + OFF_MODS); mods1 = mods0 + 5 * 6144; XC = (float*)(ws + OFF_XC); } while (0)
#define PHASE(k, ...) if (((PH_MASK >> (k)) & 1u) && lo <= (k) && (k) < hi) { LAUNDER(); __VA_ARGS__; if ((k) + 1 < hi) grid.sync(); }
#define ROWS(yf_, xl_, xc_, xol_, xoc_, m_, gi_, gp_, H_, mH_, si_, sci_, gpre_, nr_) do { RowArgs r; r.yf = (yf_); r.xin_lat = (xl_); r.xin_ctx = (xc_); r.xout_lat = (xol_); r.xout_ctx = (xoc_); \
        r.mods = (m_); r.gate_idx = (gi_); r.g_post = (gp_); r.H = (H_); r.modsH = (mH_); r.shift_idx = (si_); r.scale_idx = (sci_); r.g_pre = (gpre_); r.nrows = (nr_); phase_rows(F, r); } while (0)
#define GEMM_F32(A_, Bt_, M_, K_, C_) do { EpiF32 E{(float*)(ws + (C_)), 1024}; run_gemm(F, (const bf16_t*)(ws + (A_)), (const bf16_t*)(ws + (Bt_)), (M_), 1024, (K_), E); } while (0)
#define GEMM_UP(A_, Bt_, M_, UA_, UB_) do { EpiSeg<EM_UP> E{ws, nullptr, nullptr, (UA_), (UB_), DFF}; run_gemm(F, (const bf16_t*)(ws + (A_)), (const bf16_t*)(ws + (Bt_)), (M_), 5632, 1024, E); } while (0)

    PHASE(0, phase_prologue(F))
    PHASE(1, ROWS(nullptr, F.inp(0), F.inp(2), nullptr, nullptr, mods0, 0, nullptr, (bf16_t*)(ws + OFF_RA), mods0, 0, 1, F.inp(6), MR))
    PHASE(2, { EpiSeg<EM_IN0> E{ws, nullptr, nullptr, 0, 0, 0}; run_gemm(F, (const bf16_t*)(ws + OFF_RA), (const bf16_t*)(ws + OFF_WIN0), MR, 3072, 1024, E); })
    PHASE(3, { if (P3_PART & 1) { EpiSeg<EM_LORA> E{ws, F.inp(20), F.inp(22), 0, 0, 0}; run_gemm(F, (const bf16_t*)(ws + OFF_RD), (const bf16_t*)(ws + OFF_WL), MR, 2560, 384, E); } __syncthreads(); if (P3_PART & 2) phase_spatial_gate(F); })
    PHASE(4, phase_rwkv_scan(F))
    PHASE(5, phase_rwkv_out(F))
    PHASE(6, GEMM_F32(OFF_RA, OFF_WOUT0, MR, 1024, OFF_YF0))
    PHASE(7, ROWS((const float*)(ws + OFF_YF0), F.inp(0), F.inp(2), F.out, XC, mods0, 2, F.inp(7), (bf16_t*)(ws + OFF_RA), mods0, 3, 4, F.inp(8), MR))
    PHASE(8, GEMM_UP(OFF_RA, OFF_WUP0, MR, OFF_UA0, OFF_UB0))
    PHASE(9, phase_conv(F, (const bf16_t*)(ws + OFF_UA0), (bf16_t*)(ws + OFF_UB0), F.inp(11), F.inp(12), MR))
    PHASE(10, GEMM_F32(OFF_UB0, OFF_WDN0, MR, DFF, OFF_YF0))
    PHASE(11, ROWS((const float*)(ws + OFF_YF0), F.out, XC, F.out, XC, mods0, 5, F.inp(9), (bf16_t*)(ws + OFF_H1), mods1, 0, 1, F.inp(6) + 1024, MR))
    PHASE(12, { EpiSeg<EM_IN1> E{ws, nullptr, nullptr, 0, 0, 0}; run_gemm(F, (const bf16_t*)(ws + OFF_H1), (const bf16_t*)(ws + OFF_WIN1), MR, 2304, 1024, E); })
    PHASE(13, phase_mlstm_prep(F))
    PHASE(14, phase_mlstm_s(F))
    PHASE(15, phase_mlstm_scan(F))
    PHASE(16, phase_mlstm_out(F))
    PHASE(17, GEMM_F32(OFF_MIX1, OFF_WOUT1, ML, 1024, OFF_YF1))
    PHASE(18, ROWS((const float*)(ws + OFF_YF1), F.out, XC, F.out, XC, mods1, 2, F.inp(7) + 1024, (bf16_t*)(ws + OFF_H1F), mods1, 3, 4, F.inp(8) + 1024, ML))
    PHASE(19, GEMM_UP(OFF_H1F, OFF_WUP1, ML, OFF_UA1, OFF_UB1))
    PHASE(20, phase_conv(F, (const bf16_t*)(ws + OFF_UA1), (bf16_t*)(ws + OFF_UB1), F.inp(11) + 9 * DFF, F.inp(12) + DFF, ML))
    PHASE(21, GEMM_F32(OFF_UB1, OFF_WDN1, ML, DFF, OFF_YF1))
    PHASE(22, ROWS((const float*)(ws + OFF_YF1), F.out, XC, F.out, XC, mods1, 5, F.inp(9) + 1024, nullptr, mods1, 0, 0, nullptr, ML))
}

#ifndef MK_PER_PHASE
#define MK_PER_PHASE 1
#endif
extern "C" void kernel_launch(void* const* d_in, const int* in_sizes, int n_in, void* d_out, int out_size, void* d_ws, size_t ws_size, hipStream_t stream) {
    static int grid = 0;
    if (grid == 0) {
        if (n_in != 41 || in_sizes[0] != ML * DM || out_size != ML * DM || ws_size < WS_NEED) { fprintf(stderr, "kernel_launch: unexpected problem (n_in %d, in0 %d, out %d, ws %zu)\n", n_in, n_in > 0 ? in_sizes[0] : -1, out_size, ws_size); grid = -1; return; }
        int dev = 0, cus = 0, per_cu = 0;
        if (hipGetDevice(&dev) != hipSuccess || hipDeviceGetAttribute(&cus, hipDeviceAttributeMultiprocessorCount, dev) != hipSuccess) { grid = -1; return; }
        if (hipFuncSetAttribute((const void*)mk_fwd, hipFuncAttributeMaxDynamicSharedMemorySize, LDS_BYTES) != hipSuccess) { fprintf(stderr, "kernel_launch: hipFuncSetAttribute failed\n"); grid = -1; return; }
        if (hipOccupancyMaxActiveBlocksPerMultiprocessor(&per_cu, (const void*)mk_fwd, NTHR, LDS_BYTES) != hipSuccess || per_cu < 1) { fprintf(stderr, "kernel_launch: occupancy query failed (%d)\n", per_cu); (void)hipGetLastError(); grid = -1; return; }
        grid = cus * 1;
        fprintf(stderr, "kernel_launch: grid %d (cus %d, per_cu %d)\n", grid, cus, per_cu);
    }
    if (grid < 0) return;
    Args a{};
    for (int i = 0; i < 41; ++i) a.in[i] = (const float*)d_in[i];
    a.out = (float*)d_out; a.ws = (unsigned char*)d_ws;
#if MK_PER_PHASE
    for (int ph = 0; ph < N_PHASES; ++ph) {
        a.ph_lo = ph; a.ph_hi = ph + 1;
        void* args[] = {&a};
        hipError_t e = hipLaunchCooperativeKernel((const void*)mk_fwd, dim3(grid), dim3(NTHR), args, LDS_BYTES, stream);
        if (e != hipSuccess) { fprintf(stderr, "kernel_launch: launch of phase %d failed: %s\n", ph, hipGetErrorString(e)); break; }
    }
#else
    a.ph_lo = 0; a.ph_hi = N_PHASES;
    void* args[] = {&a};
    hipError_t e = hipLaunchCooperativeKernel((const void*)mk_fwd, dim3(grid), dim3(NTHR), args, LDS_BYTES, stream);
    if (e != hipSuccess) fprintf(stderr, "kernel_launch: cooperative launch failed: %s (grid %d)\n", hipGetErrorString(e), grid);
#endif
}
```
